# Optimizing an MI355X kernel written in HIP

```python
import math
import jax
import jax.numpy as jnp
from jax import lax
import numpy as np

D_MODEL = 1024
BATCH = 8
SEQ = 4096
DEPTH = 4

HEAD_DIM = 64
A_HEADS = D_MODEL // 4 // HEAD_DIM
A_QK_DIM = HEAD_DIM // 2
B_HEADS = D_MODEL // 2 // HEAD_DIM
C_HEADS = D_MODEL // 4 // HEAD_DIM
C_PAIRS = ((128, 1), (512, 4), (2048, 16))
C_GROUPS = len(C_PAIRS)
A_W = A_HEADS * HEAD_DIM
B_W = B_HEADS * HEAD_DIM
C_W = C_HEADS * HEAD_DIM
MIX_W = A_W + B_W + C_W
A_OFF = 0
B_OFF = A_OFF + 3 * A_W
F_OFF = B_OFF + 3 * B_W
C_OFF = F_OFF + B_HEADS
N_IN = C_OFF + 3 * C_GROUPS * C_W
D_FF = 4 * D_MODEL
N_BUCKETS = 32
MAX_DISTANCE = 2048
N_BIAS_HEADS = A_HEADS + C_GROUPS * C_HEADS
Q_BLOCK = 128
NORM_EPS = 1e-6
NEG_INF = -1e30

kernel_name = "hybrid_diff_fox_dilated_trunk"


def rmsnorm(x, g):
    xf = x.astype(jnp.float32)
    y = xf * lax.rsqrt(jnp.mean(xf * xf, axis=-1, keepdims=True) + NORM_EPS)
    return (y * g.astype(jnp.float32)).astype(x.dtype)


def t5_bucket(dist):
    max_exact = N_BUCKETS // 2
    d = jnp.maximum(dist, 0)
    df = jnp.maximum(d, 1).astype(jnp.float32)
    large = max_exact + (jnp.log(df / max_exact) / math.log(MAX_DISTANCE / max_exact)
                         * (N_BUCKETS - max_exact)).astype(jnp.int32)
    large = jnp.minimum(large, N_BUCKETS - 1)
    return jnp.where(d < max_exact, d, large)


def diff_attention(q, k, v, lam, lam_init, sub_g, bias_a):
    bsz, seq = q.shape[0], q.shape[1]
    scale = A_QK_DIM ** -0.5
    kpos = jnp.arange(seq)

    def block(i):
        q0 = i * Q_BLOCK
        qb = lax.dynamic_slice_in_dim(q, q0, Q_BLOCK, axis=1)
        dist = (q0 + jnp.arange(Q_BLOCK))[:, None] - kpos[None, :]
        bias = jnp.transpose(bias_a[t5_bucket(dist)], (2, 0, 1)).astype(jnp.float32)
        logits = jnp.einsum('bqhcd,bkhcd->bchqk', qb, k).astype(jnp.float32) * scale + bias
        logits = jnp.where(dist >= 0, logits, NEG_INF)
        p = jax.nn.softmax(logits, axis=-1)
        a = p[:, 0] - lam * p[:, 1]
        return jnp.einsum('bhqk,bkhd->bqhd', a.astype(v.dtype), v)

    out = lax.map(block, jnp.arange(seq // Q_BLOCK))
    out = jnp.moveaxis(out, 0, 1).reshape(bsz, seq, A_HEADS, HEAD_DIM)
    return rmsnorm(out, sub_g) * (1.0 - lam_init)


def forgetting_attention(q, k, v, f_logit):
    bsz, seq = q.shape[0], q.shape[1]
    scale = HEAD_DIM ** -0.5
    log_f = jax.nn.log_sigmoid(f_logit.astype(jnp.float32))
    cum = jnp.transpose(jnp.cumsum(log_f, axis=1), (0, 2, 1))
    kpos = jnp.arange(seq)

    def block(i):
        q0 = i * Q_BLOCK
        qb = lax.dynamic_slice_in_dim(q, q0, Q_BLOCK, axis=1)
        cq = lax.dynamic_slice_in_dim(cum, q0, Q_BLOCK, axis=2)
        causal = (q0 + jnp.arange(Q_BLOCK))[:, None] >= kpos[None, :]
        decay = cq[:, :, :, None] - cum[:, :, None, :]
        logits = jnp.einsum('bqhd,bkhd->bhqk', qb, k).astype(jnp.float32) * scale + decay
        logits = jnp.where(causal, logits, NEG_INF)
        p = jax.nn.softmax(logits, axis=-1)
        return jnp.einsum('bhqk,bkhd->bqhd', p.astype(v.dtype), v)

    out = lax.map(block, jnp.arange(seq // Q_BLOCK))
    return jnp.moveaxis(out, 0, 1).reshape(bsz, seq, B_HEADS, HEAD_DIM)


def dilated_attention(q, k, v, bias_c):
    bsz, seq = q.shape[0], q.shape[1]
    scale = HEAD_DIM ** -0.5
    qs = [q[:, :, g] for g in range(C_GROUPS)]
    ks = [k[:, :, g] for g in range(C_GROUPS)]
    vs = [v[:, :, g] for g in range(C_GROUPS)]

    def block(i):
        q0 = i * Q_BLOCK
        qpos = q0 + jnp.arange(Q_BLOCK)
        outs, lses = [], []
        for g, (window, dil) in enumerate(C_PAIRS):
            n_keys = window // dil + 1
            dist = jnp.arange(n_keys) * dil
            kidx = qpos[:, None] - dist[None, :]
            valid = kidx >= 0
            kidx = jnp.maximum(kidx, 0)
            kg = jnp.take(ks[g], kidx, axis=1)
            vg = jnp.take(vs[g], kidx, axis=1)
            qg = lax.dynamic_slice_in_dim(qs[g], q0, Q_BLOCK, axis=1)
            bias = bias_c[t5_bucket(dist), g * C_HEADS:(g + 1) * C_HEADS]
            logits = (jnp.einsum('bqhd,bqkhd->bhqk', qg, kg).astype(jnp.float32) * scale
                      + jnp.transpose(bias).astype(jnp.float32)[None, :, None, :])
            logits = jnp.where(valid[None, None], logits, NEG_INF)
            m = jnp.max(logits, axis=-1, keepdims=True)
            e = jnp.exp(logits - m)
            s = jnp.sum(e, axis=-1, keepdims=True)
            outs.append(jnp.einsum('bhqk,bqkhd->bqhd', (e / s).astype(vg.dtype), vg))
            lses.append((m + jnp.log(s))[..., 0])
        alpha = jax.nn.softmax(jnp.stack(lses, axis=0), axis=0)
        alpha = jnp.transpose(alpha, (0, 1, 3, 2))[..., None]
        return jnp.sum(alpha * jnp.stack(outs, axis=0).astype(jnp.float32), axis=0)

    out = lax.map(block, jnp.arange(seq // Q_BLOCK))
    return jnp.moveaxis(out, 0, 1).reshape(bsz, seq, C_HEADS, HEAD_DIM).astype(q.dtype)


def setup_inputs(seed: int = 0) -> dict:
    key = jax.random.key(seed)
    ks = jax.random.split(key, 16)
    L, D = DEPTH, D_MODEL

    def nrm(k, shape, s):
        return jax.random.normal(k, shape, jnp.float32) * s

    return {
        'x': nrm(ks[0], (BATCH, SEQ, D), 1.0),
        'norm1_g': 1.0 + nrm(ks[1], (L, D), 0.02),
        'w_in': nrm(ks[2], (L, D, N_IN), D ** -0.5),
        'b_f': 2.0 + nrm(ks[3], (L, B_HEADS), 0.1),
        'lam_q1': nrm(ks[4], (L, A_QK_DIM), 0.1),
        'lam_k1': nrm(ks[5], (L, A_QK_DIM), 0.1),
        'lam_q2': nrm(ks[6], (L, A_QK_DIM), 0.1),
        'lam_k2': nrm(ks[7], (L, A_QK_DIM), 0.1),
        'diff_norm_g': 1.0 + nrm(ks[8], (L, HEAD_DIM), 0.02),
        'w_o': nrm(ks[9], (L, MIX_W, D), MIX_W ** -0.5),
        'norm2_g': 1.0 + nrm(ks[10], (L, D), 0.02),
        'w_1': nrm(ks[11], (L, D, D_FF), D ** -0.5),
        'w_2': nrm(ks[12], (L, D_FF, D), D_FF ** -0.5),
        'rel_bias': nrm(ks[13], (N_BUCKETS, N_BIAS_HEADS), 0.5),
        'final_g': 1.0 + nrm(ks[14], (D,), 0.02),
    }


def reference(x, norm1_g, w_in, b_f, lam_q1, lam_k1, lam_q2, lam_k2, diff_norm_g,
              w_o, norm2_g, w_1, w_2, rel_bias, final_g):
    bsz, seq = x.shape[0], x.shape[1]
    bias_a = rel_bias[:, :A_HEADS]
    bias_c = rel_bias[:, A_HEADS:]
    for l in range(DEPTH):
        h = rmsnorm(x, norm1_g[l])
        proj = jnp.einsum('bsd,dn->bsn', h, w_in[l])

        qa = proj[..., A_OFF:A_OFF + A_W].reshape(bsz, seq, A_HEADS, 2, A_QK_DIM)
        ka = proj[..., A_OFF + A_W:A_OFF + 2 * A_W].reshape(bsz, seq, A_HEADS, 2, A_QK_DIM)
        va = proj[..., A_OFF + 2 * A_W:B_OFF].reshape(bsz, seq, A_HEADS, HEAD_DIM)
        lam_init = 0.8 - 0.6 * math.exp(-0.3 * l)
        lam = (jnp.exp(jnp.sum(lam_q1[l].astype(jnp.float32) * lam_k1[l].astype(jnp.float32)))
               - jnp.exp(jnp.sum(lam_q2[l].astype(jnp.float32) * lam_k2[l].astype(jnp.float32)))
               + lam_init)
        out_a = diff_attention(qa, ka, va, lam, lam_init, diff_norm_g[l], bias_a)

        qb = proj[..., B_OFF:B_OFF + B_W].reshape(bsz, seq, B_HEADS, HEAD_DIM)
        kb = proj[..., B_OFF + B_W:B_OFF + 2 * B_W].reshape(bsz, seq, B_HEADS, HEAD_DIM)
        vb = proj[..., B_OFF + 2 * B_W:F_OFF].reshape(bsz, seq, B_HEADS, HEAD_DIM)
        f_logit = proj[..., F_OFF:C_OFF] + b_f[l]
        out_b = forgetting_attention(qb, kb, vb, f_logit)

        qc = proj[..., C_OFF:C_OFF + C_GROUPS * C_W].reshape(bsz, seq, C_GROUPS, C_HEADS, HEAD_DIM)
        kc = proj[..., C_OFF + C_GROUPS * C_W:C_OFF + 2 * C_GROUPS * C_W].reshape(bsz, seq, C_GROUPS, C_HEADS, HEAD_DIM)
        vc = proj[..., C_OFF + 2 * C_GROUPS * C_W:N_IN].reshape(bsz, seq, C_GROUPS, C_HEADS, HEAD_DIM)
        out_c = dilated_attention(qc, kc, vc, bias_c)

        mixed = jnp.concatenate([out_a.reshape(bsz, seq, A_W).astype(x.dtype),
                                 out_b.reshape(bsz, seq, B_W).astype(x.dtype),
                                 out_c.reshape(bsz, seq, C_W).astype(x.dtype)], axis=-1)
        x = x + jnp.einsum('bsm,md->bsd', mixed, w_o[l])

        h2 = rmsnorm(x, norm2_g[l])
        u = jnp.square(jax.nn.relu(jnp.einsum('bsd,df->bsf', h2, w_1[l])))
        x = x + jnp.einsum('bsf,fd->bsd', u, w_2[l])
    return rmsnorm(x, final_g)
```

```cpp
#include <hip/hip_runtime.h>
#include <hip/hip_cooperative_groups.h>
#include <cstdio>
#include <cstdint>
#include <cmath>
namespace cg = cooperative_groups;

constexpr int NBATCH = 8, SEQ = 4096, DM = 1024, DEPTH = 4, FF = 4096;
constexpr int MTOK = NBATCH * SEQ;
constexpr int NIN = 4616;
constexpr int NP = 4608;
constexpr int F_OFF = 2304;
constexpr float NORM_EPS = 1e-6f;
constexpr float LOG2E = 1.4426950408889634f;
constexpr int PC_QA = 0, PC_QB = 256, PC_QC2 = 768, PC_QC0 = 1024, PC_QC1 = 1280, PC_KA = 1536, PC_VA = 1792, PC_KB = 2048, PC_VB = 2560, PC_KC = 3072, PC_VC = 3840;

constexpr size_t MiB = 1u << 20;
constexpr size_t WS_CTL = 0;
constexpr size_t WS_SS = 64 * 1024;
constexpr size_t WS_LOGF = 3 * MiB;
constexpr size_t WS_BIASA = 4 * MiB;
constexpr size_t WS_TABC = 4 * MiB + 64 * 1024;
constexpr size_t WS_WIN = 8 * MiB, WS_WO = 44 * MiB, WS_W1 = 52 * MiB, WS_W2 = 84 * MiB;
constexpr size_t WS_XN = 116 * MiB;
constexpr size_t WS_PROJ = 180 * MiB;
constexpr size_t WS_END = 468 * MiB;
constexpr float SS_SCALE = 16777216.0f, SS_INV = 1.0f / 16777216.0f;

#define DI __device__ __forceinline__
#define LAS __attribute__((address_space(3)))
typedef float f32x16 __attribute__((ext_vector_type(16)));
typedef short s16x4 __attribute__((ext_vector_type(4)));
typedef unsigned u32x2 __attribute__((ext_vector_type(2)));
#define LDS_WAIT() asm volatile("s_waitcnt lgkmcnt(0)" ::: "memory")
DI int opaque_tid() { int t = threadIdx.x; asm volatile("" : "+v"(t)); return t; }
DI int opaque_bid() { int b = blockIdx.x; asm volatile("" : "+s"(b)); return b; }

namespace pg8 {
#define PG8_LAS __attribute__((address_space(3)))
typedef unsigned short bf16_t;
typedef short bf16x8 __attribute__((ext_vector_type(8)));
typedef float f32x4 __attribute__((ext_vector_type(4)));
typedef unsigned u32x4 __attribute__((ext_vector_type(4)));
constexpr int BM = 256, BK = 64, HALF = 128, HTB = HALF * BK * 2  , STAGE_BYTES = 8 * HTB, NXCD = 8, WGM = 8;

__host__ __device__ __forceinline__ int lds_byte(int r, int c) { const int st = (r >> 4) * 2 + (c >> 5), rr = r & 15, cc = c & 31, ob = rr * 64 + cc * 2; return st * 1024 + (ob ^ (((ob >> 9) & 1) << 5)); }
__host__ __device__ __forceinline__ void stage_rc(int b, int& R, int& C) { const int st = b / 1024, sb = b % 1024, swz = sb ^ (((sb >> 9) & 1) << 5); R = (st >> 1) * 16 + swz / 64; C = (st & 1) * 32 + (swz % 64) / 2; }
__host__ __device__ __forceinline__ int perm32(int rho) { const int n = rho >> 4, i = rho & 15; return 8 * (i >> 2) + 4 * n + (i & 3); }

struct Unit { int pm, pn; };
struct Gemm { const bf16_t* A; const bf16_t* Bt; int M, N, K, lda; };

struct StaticOrder {
    int nM, nN, nwg, G, c;
    __host__ __device__ void init(int M, int N, int G_, int c_) { nM = M / BM; nN = N / BM; nwg = nM * nN; G = G_; c = c_; }
    __host__ __device__ bool next(int i, Unit& u) const {
        const long L = (long)i * G + c; if (L >= nwg) return false;
        int wgid = (int)L; { const int q = nwg / NXCD, r = nwg % NXCD, xcd = wgid % NXCD, off = wgid / NXCD; wgid = (xcd < r ? xcd * (q + 1) : r * (q + 1) + (xcd - r) * q) + off; }
        const int nig = WGM * nN, gid = wgid / nig, fm = gid * WGM, gsz = (nM - fm) < WGM ? (nM - fm) : WGM;
        u.pm = fm + ((wgid % nig) % gsz); u.pn = (wgid % nig) / gsz; return true;
    }
    __device__ __forceinline__ void a_ready(const Unit&) const {}
    __device__ __forceinline__ void done(const Unit&) const {}
};

__device__ __forceinline__ unsigned cvt_pk_bf16(float lo, float hi) { unsigned r; asm volatile("v_cvt_pk_bf16_f32 %0, %1, %2" : "=v"(r) : "v"(lo), "v"(hi)); return r; }
typedef float f32x2 __attribute__((ext_vector_type(2)));
__device__ __forceinline__ float row_rs(const unsigned long long* ss, int row) { return 1.0f / sqrtf((float)ss[row] * (SS_INV / 1024.0f) + NORM_EPS); }
template <int MODE> struct EpiScaleBf16 {
    static constexpr bool PERM = true, AFTER_DRAIN = false;
    bf16_t* O; int ldc; const unsigned long long* ss;
    __device__ __forceinline__ void operator()(const f32x4 (&acc)[2][2][4][2], const Unit& u, int wr, int wc, int fr, int fq) const {
        const int row0 = u.pm * BM + wr * 64 + fr, col0 = u.pn * BM + wc * 32 + 8 * fq;
        float sc = 1.f;
        if (MODE == 0) { if (u.pn == 0) sc = 0.17677669529663687f * LOG2E; else if (u.pn < 6) sc = 0.125f * LOG2E; }
#pragma unroll
        for (int ai = 0; ai < 2; ++ai)
#pragma unroll
            for (int m = 0; m < 4; ++m) { const int row = row0 + ai * HALF + m * 16; const float rs = row_rs(ss, row) * sc; bf16_t* rowp = O + (size_t)row * ldc + col0;
#pragma unroll
                for (int bj = 0; bj < 2; ++bj) { f32x4 v0 = acc[ai][bj][m][0] * rs, v1 = acc[ai][bj][m][1] * rs;
                    if (MODE == 1) {
#pragma unroll
                        for (int e = 0; e < 4; ++e) { const float a = fmaxf(v0[e], 0.f), b = fmaxf(v1[e], 0.f); v0[e] = a * a; v1[e] = b * b; } }
                    u32x4 w; w.x = cvt_pk_bf16(v0[0], v0[1]); w.y = cvt_pk_bf16(v0[2], v0[3]); w.z = cvt_pk_bf16(v1[0], v1[1]); w.w = cvt_pk_bf16(v1[2], v1[3]);
                    *(u32x4*)(rowp + bj * HALF) = w; } }
    }
};
struct EpiRes {
    static constexpr bool PERM = false, AFTER_DRAIN = false;
    float* X; bf16_t* XN; unsigned long long* ssout;
    __device__ __forceinline__ void operator()(const f32x4 (&acc)[2][2][4][2], const Unit& u, int wr, int wc, int fr, int fq) const {
        typedef unsigned u32x2v __attribute__((ext_vector_type(2)));
        const int col0 = u.pn * BM + wc * 32 + 4 * fq;
#pragma unroll
        for (int ai = 0; ai < 2; ++ai)
#pragma unroll
            for (int m = 0; m < 4; ++m) { const int row = u.pm * BM + ai * HALF + wr * 64 + m * 16 + fr; const size_t off = (size_t)row * DM + col0; float s = 0.f;
#pragma unroll
                for (int bj = 0; bj < 2; ++bj)
#pragma unroll
                    for (int n = 0; n < 2; ++n) { float* p = X + off + bj * HALF + n * 16; const f32x4 x = *(const f32x4*)p + acc[ai][bj][m][n]; *(f32x4*)p = x;
                        u32x2v w; w.x = cvt_pk_bf16(x[0], x[1]); w.y = cvt_pk_bf16(x[2], x[3]); *(u32x2v*)(XN + off + bj * HALF + n * 16) = w;
                        s += (x[0] * x[0] + x[1] * x[1]) + (x[2] * x[2] + x[3] * x[3]); }
                s += __shfl_xor(s, 16); s += __shfl_xor(s, 32);
                if (fq == 0) atomicAdd(ssout + row, (unsigned long long)(s * SS_SCALE)); }
    }
};

template <class Epi, class Sched, bool ALIGN_EPI = false, bool SP2 = false>
__device__ __forceinline__ void gemm_phase(PG8_LAS unsigned char* lds, const Gemm g, const Sched& S, const Epi& E) {
    const int tid = opaque_tid(), wid = __builtin_amdgcn_readfirstlane(tid >> 6), lane = tid & 63, wr = wid >> 2, wc = wid & 3, fr = lane & 15, fq = lane >> 4;
    const int K = g.K, nt = K / BK;
    unsigned voffA[2], voffB[2];
#pragma unroll
    for (int i = 0; i < 2; ++i) { int R, C; stage_rc(tid * 16 + i * 8192, R, C); const int Rb = Epi::PERM ? ((R & ~31) + perm32(R & 31)) : R;
        voffA[i] = (unsigned)(R * g.lda + C) * 2u; voffB[i] = (unsigned)(Rb * K + C) * 2u; }
    const size_t kstep = (size_t)(BK * 2);
    const size_t hstepA = (size_t)HALF * g.lda * 2, hstepB = (size_t)HALF * K * 2;
    const size_t tstepA = 2 * hstepA, tstepB = 2 * hstepB;
    const unsigned ldsw = (unsigned)wid * 1024u;
    const int aoff = lds_byte(wr * 64 + fr, fq * 8), boff = lds_byte(wc * 32 + fr, fq * 8);
#define PG8_SA(b, h) (((b) * 2 + (h)) * HTB)
#define PG8_SB(b, h) ((4 + (b) * 2 + (h)) * HTB)
#define PG8_STAGE(bufoff, gbase, voff) do { _Pragma("unroll") for (int _i = 0; _i < 2; ++_i) \
        __builtin_amdgcn_global_load_lds((const unsigned*)((const char*)(gbase) + (voff)[_i]), (PG8_LAS unsigned*)(lds + (bufoff) + ldsw + _i * 8192), 16, 0, 0); } while (0)
#define PG8_LDA(dst, b, h) do { _Pragma("unroll") for (int m = 0; m < 4; ++m) _Pragma("unroll") for (int k = 0; k < 2; ++k) dst[m][k] = *(const PG8_LAS bf16x8*)(lds + PG8_SA(b, h) + aoff + m * 2048 + k * 1024); } while (0)
#define PG8_LDB(dst, b, h) do { _Pragma("unroll") for (int n = 0; n < 2; ++n) _Pragma("unroll") for (int k = 0; k < 2; ++k) dst[n][k] = *(const PG8_LAS bf16x8*)(lds + PG8_SB(b, h) + boff + n * 2048 + k * 1024); } while (0)
#define PG8_MMA(ai, bj, At, Bt) do { __builtin_amdgcn_s_setprio(1); _Pragma("unroll") for (int m = 0; m < 4; ++m) _Pragma("unroll") for (int n = 0; n < 2; ++n) _Pragma("unroll") for (int k = 0; k < 2; ++k) \
        acc[ai][bj][m][n] = __builtin_amdgcn_mfma_f32_16x16x32_bf16(Bt[n][k], At[m][k], acc[ai][bj][m][n], 0, 0, 0); __builtin_amdgcn_s_setprio(0); } while (0)
#define PG8_WAIT_V(n) asm volatile("s_waitcnt vmcnt(" #n ")" ::: "memory")
#define PG8_WAIT_L(n) asm volatile("s_waitcnt lgkmcnt(" #n ")" ::: "memory")
#define PG8_BAR __builtin_amdgcn_s_barrier()
#define PG8_SCHED __builtin_amdgcn_sched_barrier(0)
    Unit cur, nxt; int ui = 0;
    if (!S.next(0, cur)) return;
    f32x4 acc[2][2][4][2];
#pragma unroll
    for (int a = 0; a < 2; ++a)
#pragma unroll
        for (int b = 0; b < 2; ++b)
#pragma unroll
            for (int m = 0; m < 4; ++m)
#pragma unroll
                for (int n = 0; n < 2; ++n) acc[a][b][m][n] = (f32x4){0.f, 0.f, 0.f, 0.f};
    bf16x8 At[4][2], B0[2][2], B1[2][2];
    const char* cA = (const char*)g.A + (size_t)cur.pm * tstepA; const char* cB = (const char*)g.Bt + (size_t)cur.pn * tstepB;
    S.a_ready(cur);
    if constexpr (SP2) {
        PG8_STAGE(PG8_SB(0, 0), cB, voffB); PG8_STAGE(PG8_SB(0, 1), cB + hstepB, voffB); PG8_STAGE(PG8_SA(0, 0), cA, voffA); PG8_STAGE(PG8_SA(0, 1), cA + hstepA, voffA);
        if (wr == 1) PG8_BAR;
        PG8_WAIT_V(2); PG8_BAR;
        PG8_STAGE(PG8_SB(1, 0), cB + kstep, voffB); PG8_STAGE(PG8_SA(1, 0), cA + kstep, voffA); PG8_STAGE(PG8_SB(1, 1), cB + hstepB + kstep, voffB);
        PG8_WAIT_V(6); PG8_BAR;
    } else {
        PG8_STAGE(PG8_SB(0, 0), cB, voffB); PG8_STAGE(PG8_SA(0, 0), cA, voffA); PG8_STAGE(PG8_SB(0, 1), cB + hstepB, voffB); PG8_STAGE(PG8_SA(0, 1), cA + hstepA, voffA);
        if (wr == 1) PG8_BAR;
        PG8_WAIT_V(4); PG8_BAR;
        PG8_STAGE(PG8_SB(1, 0), cB + kstep, voffB); PG8_STAGE(PG8_SA(1, 0), cA + kstep, voffA); PG8_STAGE(PG8_SB(1, 1), cB + hstepB + kstep, voffB);
        PG8_WAIT_V(6); PG8_BAR;
    }
    for (;;) {
        const bool has_next = S.next(ui + 1, nxt);
        const char* nA = has_next ? (const char*)g.A + (size_t)nxt.pm * tstepA : cA; const char* nB = has_next ? (const char*)g.Bt + (size_t)nxt.pn * tstepB : cB;
        for (int t = 0; t < nt; t += 2) {
            const bool last = (t == nt - 2);
            const char* a1 = cA + (size_t)(t + 1) * kstep;
            const char* a2 = last ? nA : cA + (size_t)(t + 2) * kstep; const char* b2 = last ? nB : cB + (size_t)(t + 2) * kstep;
            const char* a3 = a2 + kstep; const char* b3 = b2 + kstep;
            if (last && has_next) S.a_ready(nxt);
            if constexpr (SP2) {
            PG8_LDB(B0, 0, 0); PG8_LDB(B1, 0, 1); PG8_SCHED; PG8_LDA(At, 0, 0); PG8_STAGE(PG8_SA(1, 1), a1 + hstepA, voffA);
            PG8_WAIT_V(8); PG8_WAIT_L(0); PG8_BAR; PG8_MMA(0, 0, At, B0); PG8_MMA(0, 1, At, B1); PG8_BAR; PG8_SCHED;
            PG8_LDA(At, 0, 1); PG8_STAGE(PG8_SB(0, 0), b2, voffB); PG8_STAGE(PG8_SB(0, 1), b2 + hstepB, voffB); PG8_STAGE(PG8_SA(0, 0), a2, voffA);
            PG8_WAIT_V(8); PG8_WAIT_L(0); PG8_BAR; PG8_MMA(1, 0, At, B0); PG8_MMA(1, 1, At, B1); PG8_BAR; PG8_SCHED;
            PG8_LDB(B0, 1, 0); PG8_LDB(B1, 1, 1); PG8_SCHED; PG8_LDA(At, 1, 0); PG8_STAGE(PG8_SA(0, 1), a2 + hstepA, voffA);
            PG8_WAIT_V(8); PG8_WAIT_L(0); PG8_BAR; PG8_MMA(0, 0, At, B0); PG8_MMA(0, 1, At, B1); PG8_BAR; PG8_SCHED;
            PG8_LDA(At, 1, 1); PG8_STAGE(PG8_SB(1, 0), b3, voffB); PG8_STAGE(PG8_SB(1, 1), b3 + hstepB, voffB); PG8_STAGE(PG8_SA(1, 0), a3, voffA);
            PG8_WAIT_V(8); PG8_WAIT_L(0); PG8_BAR; PG8_MMA(1, 0, At, B0); PG8_MMA(1, 1, At, B1); PG8_BAR; PG8_SCHED;
            } else {
            PG8_LDB(B0, 0, 0); PG8_SCHED; PG8_LDA(At, 0, 0); PG8_STAGE(PG8_SA(1, 1), a1 + hstepA, voffA);
            PG8_WAIT_L(8); PG8_BAR; PG8_WAIT_L(0); PG8_MMA(0, 0, At, B0); PG8_BAR; PG8_SCHED;
            PG8_LDB(B1, 0, 1); PG8_STAGE(PG8_SB(0, 0), b2, voffB);
            PG8_BAR; PG8_WAIT_L(0); PG8_MMA(0, 1, At, B1); PG8_BAR;
            PG8_LDA(At, 0, 1); PG8_STAGE(PG8_SA(0, 0), a2, voffA);
            PG8_BAR; PG8_WAIT_L(0); PG8_MMA(1, 0, At, B0); PG8_BAR; PG8_SCHED;
            PG8_STAGE(PG8_SB(0, 1), b2 + hstepB, voffB);
            PG8_WAIT_V(6); PG8_BAR; PG8_MMA(1, 1, At, B1); PG8_BAR;
            PG8_LDB(B0, 1, 0); PG8_SCHED; PG8_LDA(At, 1, 0); PG8_STAGE(PG8_SA(0, 1), a2 + hstepA, voffA);
            PG8_WAIT_L(8); PG8_BAR; PG8_WAIT_L(0); PG8_MMA(0, 0, At, B0); PG8_BAR; PG8_SCHED;
            PG8_LDB(B1, 1, 1); PG8_STAGE(PG8_SB(1, 0), b3, voffB);
            PG8_BAR; PG8_WAIT_L(0); PG8_MMA(0, 1, At, B1); PG8_BAR;
            PG8_LDA(At, 1, 1); PG8_STAGE(PG8_SA(1, 0), a3, voffA);
            PG8_BAR; PG8_WAIT_L(0); PG8_MMA(1, 0, At, B0); PG8_BAR; PG8_SCHED;
            PG8_STAGE(PG8_SB(1, 1), b3 + hstepB, voffB);
            PG8_WAIT_V(6); PG8_BAR; PG8_MMA(1, 1, At, B1); PG8_BAR;
            }
        }
        if constexpr (ALIGN_EPI) { if (wr == 0) PG8_BAR; }
        if constexpr (!Epi::AFTER_DRAIN) { E(acc, cur, wr, wc, fr, fq); S.done(cur); }
        if (!has_next) break;
#pragma unroll
        for (int a = 0; a < 2; ++a)
#pragma unroll
            for (int b = 0; b < 2; ++b)
#pragma unroll
                for (int m = 0; m < 4; ++m)
#pragma unroll
                    for (int n = 0; n < 2; ++n) acc[a][b][m][n] = (f32x4){0.f, 0.f, 0.f, 0.f};
        cur = nxt; cA = nA; cB = nB; ++ui;
        if constexpr (ALIGN_EPI) { if (wr == 1) PG8_BAR; }
    }
    PG8_WAIT_V(0);
    if constexpr (!ALIGN_EPI) { if (wr == 0) PG8_BAR; }
    PG8_BAR;
    if constexpr (Epi::AFTER_DRAIN) { E.fused(acc, cur, wr, wc, fr, fq, lds, wid, lane); S.done(cur); }
#undef PG8_SA
#undef PG8_SB
#undef PG8_STAGE
#undef PG8_LDA
#undef PG8_LDB
#undef PG8_MMA
#undef PG8_WAIT_V
#undef PG8_WAIT_L
#undef PG8_BAR
#undef PG8_SCHED
}
}
typedef unsigned short bf16;
typedef float f32x4 __attribute__((ext_vector_type(4)));
typedef short bf16x8 __attribute__((ext_vector_type(8)));
typedef unsigned u32x4 __attribute__((ext_vector_type(4)));
typedef short v4i16_t __attribute__((ext_vector_type(4)));
typedef float f32x2_t __attribute__((ext_vector_type(2)));
typedef __bf16 bf16x2_t __attribute__((ext_vector_type(2)));
DI unsigned cvtpk(float lo, float hi) { f32x2_t v = {lo, hi}; bf16x2_t b = __builtin_convertvector(v, bf16x2_t); return __builtin_bit_cast(unsigned, b); }
DI float bf2f(unsigned short u) { return __uint_as_float((unsigned)u << 16); }
DI float wave_sum(float v) {
#pragma unroll
    for (int o = 1; o < 64; o <<= 1) v += __shfl_xor(v, o);
    return v;
}
struct Ctx {
    const float *x, *norm1_g, *w_in, *b_f, *lam_q1, *lam_k1, *lam_q2, *lam_k2, *diff_g, *w_o, *norm2_g, *w_1, *w_2, *rel_bias, *final_g;
    float* out; unsigned char* ws;
    bf16 *win_t, *wo_t, *w1_t, *w2_t, *xn, *proj;
    unsigned long long* ss; float* logf; float* biasA; float* tabC; float* lamv; unsigned* ctl;
};

DI int colmap(int t) {
    switch (t) { case 0: return 0; case 1: return 768; case 2: return 1024; case 3: return 2824; case 4: return 2312; case 5: return 2568; case 6: return 256; case 7: return 512;
                 case 8: return 1280; case 9: return 1536; case 10: return 1792; case 11: return 2048; case 12: return 3080; case 13: return 3336; case 14: return 3592;
                 case 15: return 3848; case 16: return 4104; default: return 4360; }
}
DI void p0_transpose_item(const float* W, int ldw, int n0src, int k0, const float* g, bf16* WT, int K, int nrow0, LAS float* scr, int lane) {
#pragma unroll 8
    for (int i = 0; i < 32; ++i) { const int kk = 2 * i + (lane >> 5); float v = W[(size_t)(k0 + kk) * ldw + n0src + (lane & 31)]; if (g) v *= g[k0 + kk]; scr[kk * 33 + (lane & 31)] = v; }
    LDS_WAIT();
    const int c = lane & 7;
#pragma unroll
    for (int j = 0; j < 4; ++j) { const int n = (lane >> 3) + 8 * j; const LAS float* s = scr + (8 * c) * 33 + n;
        u32x4 o; o.x = cvtpk(s[0 * 33], s[1 * 33]); o.y = cvtpk(s[2 * 33], s[3 * 33]); o.z = cvtpk(s[4 * 33], s[5 * 33]); o.w = cvtpk(s[6 * 33], s[7 * 33]);
        *(u32x4*)(WT + (size_t)(nrow0 + n) * K + k0 + 8 * c) = o; }
    LDS_WAIT();
}
DI int t5_bucket(int d) {
    if (d < 16) return d;
    int lg = 16 + (int)(logf((float)d / 16.0f) / 4.852030263919617f * 16.0f);
    return lg < 31 ? lg : 31;
}
DI void p0_prologue(const Ctx& c, LAS unsigned char* lds) {
    const int tid = opaque_tid(), lane = tid & 63, wave = __builtin_amdgcn_readfirstlane(tid >> 6);
    const int G = gridDim.x, bid = opaque_bid(), gw = bid * 8 + wave, NGW = G * 8, gt = bid * 512 + tid, NGT = G * 512;
    LAS float* scr = (LAS float*)(lds + wave * 16384);
    constexpr int I_IN = 16 * 144, I_O = 16 * 32, I_1 = 16 * 128, I_2 = 64 * 32, I_L = I_IN + I_O + I_1 + I_2;
    for (int it = gw; it < DEPTH * I_L; it += NGW) {
        const int l = it / I_L; int r = it - l * I_L;
        if (r < I_IN) { const int kb = r / 144, nb = r - kb * 144, np0 = nb * 32;
            p0_transpose_item(c.w_in + (size_t)l * DM * NIN, NIN, colmap(np0 >> 8) + (np0 & 255), kb * 64, c.norm1_g + l * DM, c.win_t + (size_t)l * NP * DM, DM, np0, scr, lane); continue; }
        r -= I_IN;
        if (r < I_O) { const int kb = r / 32, nb = r - kb * 32;
            p0_transpose_item(c.w_o + (size_t)l * DM * DM, DM, nb * 32, kb * 64, nullptr, c.wo_t + (size_t)l * DM * DM, DM, nb * 32, scr, lane); continue; }
        r -= I_O;
        if (r < I_1) { const int kb = r / 128, nb = r - kb * 128;
            p0_transpose_item(c.w_1 + (size_t)l * DM * FF, FF, nb * 32, kb * 64, c.norm2_g + l * DM, c.w1_t + (size_t)l * FF * DM, DM, nb * 32, scr, lane); continue; }
        r -= I_1;
        { const int kb = r / 32, nb = r - kb * 32;
            p0_transpose_item(c.w_2 + (size_t)l * FF * DM, DM, nb * 32, kb * 64, nullptr, c.w2_t + (size_t)l * DM * FF, FF, nb * 32, scr, lane); }
    }
    for (int m = gw; m < MTOK; m += NGW) {
        const f32x4* xr = (const f32x4*)(c.x + (size_t)m * DM) + lane; f32x4* orow = (f32x4*)(c.out + (size_t)m * DM) + lane;
        unsigned long long* o8 = (unsigned long long*)(c.xn + (size_t)m * DM) + lane;
        float s = 0.f;
#pragma unroll
        for (int j = 0; j < 4; ++j) { const f32x4 v = xr[64 * j]; orow[64 * j] = v; s += (v.x * v.x + v.y * v.y) + (v.z * v.z + v.w * v.w);
            o8[64 * j] = (unsigned long long)cvtpk(v.x, v.y) | ((unsigned long long)cvtpk(v.z, v.w) << 32); }
        s = wave_sum(s);
        if (lane == 0) c.ss[m] = (unsigned long long)(s * SS_SCALE);
    }
    for (int i = gt; i < 8 * MTOK; i += NGT) c.ss[MTOK + i] = 0ull;
    if (gt < DEPTH) { c.ctl[64 * gt] = 0u; float d1 = 0.f, d2 = 0.f;
        for (int i = 0; i < 32; ++i) { d1 += c.lam_q1[gt * 32 + i] * c.lam_k1[gt * 32 + i]; d2 += c.lam_q2[gt * 32 + i] * c.lam_k2[gt * 32 + i]; }
        c.lamv[gt] = expf(d1) - expf(d2) + (0.8f - 0.6f * expf(-0.3f * (float)gt)); }
    for (int i = gt; i < 4 * 4096; i += NGT) { const int h = i >> 12, d = i & 4095; c.biasA[i] = c.rel_bias[t5_bucket(d) * 16 + h] * LOG2E; }
    for (int i = gt; i < 4 * 396; i += NGT) { const int h = i / 396, r = i - h * 396, g = r / 132, n = r - g * 132; const int dil = g == 0 ? 1 : (g == 1 ? 4 : 16);
        c.tabC[i] = (n <= 128) ? c.rel_bias[t5_bucket(n * dil) * 16 + 4 + 4 * g + h] * LOG2E : 0.f; }
}

DI void fgate_phase(const Ctx& c, int l, LAS unsigned char* lds) {
    const int tid = opaque_tid(), lane = tid & 63, wave = __builtin_amdgcn_readfirstlane(tid >> 6);
    const int gw = opaque_bid() * 8 + wave, NGW = gridDim.x * 8;
    LAS float* wg = (LAS float*)lds;
    const float* wsrc = c.w_in + (size_t)l * DM * NIN + F_OFF; const float* g1 = c.norm1_g + l * DM;
    for (int i = tid; i < 8192; i += 512) { const int k = i >> 3, h = i & 7; wg[i] = wsrc[(size_t)k * NIN + h] * g1[k]; }
    __syncthreads();
    const unsigned long long* ss = c.ss + (size_t)(2 * l) * MTOK;
    for (int row = gw; row < MTOK; row += NGW) {
        const unsigned long long* xr = (const unsigned long long*)(c.xn + (size_t)row * DM) + lane;
        float acc[8];
#pragma unroll
        for (int h = 0; h < 8; ++h) acc[h] = 0.f;
#pragma unroll 1
        for (int j = 0; j < 4; ++j) { const unsigned long long w = xr[64 * j];
#pragma unroll
            for (int e = 0; e < 4; ++e) { const float xv = bf2f((unsigned short)(w >> (16 * e))); const int k = 4 * lane + 256 * j + e;
                const f32x4 wa = *(const LAS f32x4*)(wg + k * 8), wb = *(const LAS f32x4*)(wg + k * 8 + 4);
                acc[0] += xv * wa.x; acc[1] += xv * wa.y; acc[2] += xv * wa.z; acc[3] += xv * wa.w; acc[4] += xv * wb.x; acc[5] += xv * wb.y; acc[6] += xv * wb.z; acc[7] += xv * wb.w; } }
#pragma unroll
        for (int h = 0; h < 8; ++h) acc[h] = wave_sum(acc[h]);
        float v = acc[0];
#pragma unroll
        for (int h = 1; h < 8; ++h) v = (lane == h) ? acc[h] : v;
        if (lane < 8) { const float f = pg8::row_rs(ss, row) * v + c.b_f[l * 8 + lane];
            const float ls = fminf(f, 0.f) - log1pf(expf(-fabsf(f)));
            const int b = row >> 12, t = row & 4095; c.logf[(size_t)(b * 8 + lane) * SEQ + t] = ls * LOG2E; }
    }
    __syncthreads();
}

DI void final_phase(const Ctx& c) {
    const int tid = opaque_tid(), lane = tid & 63, wave = __builtin_amdgcn_readfirstlane(tid >> 6);
    const int gw = opaque_bid() * 8 + wave, NGW = gridDim.x * 8;
    const unsigned long long* ss = c.ss + (size_t)8 * MTOK;
    const f32x4* gp = (const f32x4*)c.final_g + lane;
    f32x4 g4[4];
#pragma unroll
    for (int j = 0; j < 4; ++j) g4[j] = gp[64 * j];
    for (int m = gw; m < MTOK; m += NGW) { f32x4* orow = (f32x4*)(c.out + (size_t)m * DM) + lane; const float rs = pg8::row_rs(ss, m);
#pragma unroll
        for (int j = 0; j < 4; ++j) { const f32x4 v = orow[64 * j]; orow[64 * j] = v * rs * g4[j]; } }
}

namespace att {
constexpr int L_K = 0, L_V = 16384, L_TAB = 32768, L_WSF = 49152, L_STG = 53248, L_SLOT = 118784;
constexpr int N_UNITS = 256 + 16 * 96;
#define NEG_INF_F (-__builtin_inff())
#define MFMA32(a, b, c) __builtin_amdgcn_mfma_f32_32x32x16_bf16((a), (b), (c), 0, 0, 0)
DI int crow(int r, int hi) { return (r & 3) + 8 * (r >> 2) + 4 * hi; }
DI s16x4 vtr(LAS const unsigned char* p) { return __builtin_bit_cast(s16x4, __builtin_amdgcn_ds_read_tr16_b64_v4i16((LAS v4i16_t*)p)); }
DI float swap_max(float a) { auto rr = __builtin_amdgcn_permlane32_swap(__float_as_uint(a), __float_as_uint(a), false, false); return fmaxf(__uint_as_float(rr[0]), __uint_as_float(rr[1])); }
DI float swap_sum(float a) { auto rr = __builtin_amdgcn_permlane32_swap(__float_as_uint(a), __float_as_uint(a), false, false); return __uint_as_float(rr[0]) + __uint_as_float(rr[1]); }

DI void softmax_pv(f32x16& p, f32x16& o0, f32x16& o1, float& mhat, float& l, LAS float* wsa, LAS const unsigned char* vb, int r32, int hi) {
    float a = fmaxf(fmaxf(p[0], p[1]), fmaxf(p[2], p[3]));
#pragma unroll
    for (int r = 4; r < 16; r += 4) a = fmaxf(a, fmaxf(fmaxf(p[r], p[r + 1]), fmaxf(p[r + 2], p[r + 3])));
    a = swap_max(a);
    bool resc = false;
    if (__any(a > 8.0f)) {
        const float dl = fmaxf(a, 0.f); mhat += dl;
#pragma unroll
        for (int r = 0; r < 16; ++r) p[r] -= dl;
        const float f = __builtin_amdgcn_exp2f(-dl); l *= f; if (hi == 0) wsa[r32] = f; resc = true;
    }
    float s = 0.f;
#pragma unroll
    for (int r = 0; r < 16; ++r) { p[r] = __builtin_amdgcn_exp2f(p[r]); s += p[r]; }
    l += s;
    if (resc) { LDS_WAIT();
#pragma unroll
        for (int g = 0; g < 4; ++g) { const f32x4 f4 = *(const LAS f32x4*)(wsa + 8 * g + 4 * hi);
#pragma unroll
            for (int e = 0; e < 4; ++e) { o0[4 * g + e] *= f4[e]; o1[4 * g + e] *= f4[e]; } } }
    u32x4 w0, w1;
    w0.x = cvtpk(p[0], p[1]); w0.y = cvtpk(p[2], p[3]); w0.z = cvtpk(p[4], p[5]); w0.w = cvtpk(p[6], p[7]);
    w1.x = cvtpk(p[8], p[9]); w1.y = cvtpk(p[10], p[11]); w1.z = cvtpk(p[12], p[13]); w1.w = cvtpk(p[14], p[15]);
    const bf16x8 pa0 = __builtin_bit_cast(bf16x8, w0), pa1 = __builtin_bit_cast(bf16x8, w1);
    { const s16x4 a0 = vtr(vb), a1 = vtr(vb + 512), b0 = vtr(vb + 1024), b1 = vtr(vb + 1536);
      o0 = MFMA32(pa0, __builtin_shufflevector(a0, a1, 0, 1, 2, 3, 4, 5, 6, 7), o0);
      o0 = MFMA32(pa1, __builtin_shufflevector(b0, b1, 0, 1, 2, 3, 4, 5, 6, 7), o0); }
    { const s16x4 a0 = vtr(vb + 2048), a1 = vtr(vb + 2048 + 512), b0 = vtr(vb + 2048 + 1024), b1 = vtr(vb + 2048 + 1536);
      o1 = MFMA32(pa0, __builtin_shufflevector(a0, a1, 0, 1, 2, 3, 4, 5, 6, 7), o1);
      o1 = MFMA32(pa1, __builtin_shufflevector(b0, b1, 0, 1, 2, 3, 4, 5, 6, 7), o1); }
}

template <int TYPE> DI void finish(const f32x16& oa0, const f32x16& oa1, const f32x16& ob0, const f32x16& ob1, float la, float lb, float lam, float oscale, const float* subg,
                                   LAS float* wsf, LAS float* stg, bf16* orow0, size_t rstride, int lane, int r32, int hi) {
    la = swap_sum(la); if (hi == 0) wsf[64 + r32] = la;
    if (TYPE == 0) { lb = swap_sum(lb); if (hi == 0) wsf[96 + r32] = lb; }
    LDS_WAIT();
#pragma unroll
    for (int g = 0; g < 4; ++g) {
        const f32x4 l0 = *(const LAS f32x4*)(wsf + 64 + 8 * g + 4 * hi);
        f32x4 l1 = l0; if (TYPE == 0) l1 = *(const LAS f32x4*)(wsf + 96 + 8 * g + 4 * hi);
#pragma unroll
        for (int e = 0; e < 4; ++e) { const int r = 4 * g + e, row = e + 8 * g + 4 * hi; const float i0 = __builtin_amdgcn_rcpf(l0[e]);
            float v0 = oa0[r] * i0, v1 = oa1[r] * i0;
            if (TYPE == 0) { const float i1 = lam * __builtin_amdgcn_rcpf(l1[e]); v0 -= ob0[r] * i1; v1 -= ob1[r] * i1; }
            stg[row * 64 + r32] = v0; stg[row * 64 + 32 + r32] = v1; }
    }
    LDS_WAIT();
    const int c8 = (lane & 7) * 8;
    f32x4 ga = {1.f, 1.f, 1.f, 1.f}, gb = ga;
    if (TYPE == 0) { ga = *(const f32x4*)(subg + c8); gb = *(const f32x4*)(subg + c8 + 4); }
#pragma unroll
    for (int it = 0; it < 4; ++it) { const int row = it * 8 + (lane >> 3);
        f32x4 a = *(const LAS f32x4*)(stg + row * 64 + c8), b = *(const LAS f32x4*)(stg + row * 64 + c8 + 4);
        if (TYPE == 0) { float q = (a.x * a.x + a.y * a.y) + (a.z * a.z + a.w * a.w) + (b.x * b.x + b.y * b.y) + (b.z * b.z + b.w * b.w);
            q += __shfl_xor(q, 1); q += __shfl_xor(q, 2); q += __shfl_xor(q, 4);
            const float rs = oscale / sqrtf(q * (1.0f / 64.0f) + NORM_EPS); a = a * rs * ga; b = b * rs * gb; }
        u32x4 w; w.x = cvtpk(a.x, a.y); w.y = cvtpk(a.z, a.w); w.z = cvtpk(b.x, b.y); w.w = cvtpk(b.z, b.w);
        *(u32x4*)(orow0 + (size_t)row * rstride + c8) = w; }
    LDS_WAIT();
}

template <int TYPE> DI void unit_ab(const Ctx& c, int layer, int b, int h, int qb, LAS unsigned char* lds) {
    const int tid = opaque_tid(), lane = tid & 63, wid = __builtin_amdgcn_readfirstlane(tid >> 6), r32 = lane & 31, hi = lane >> 5;
    const int qcol = (TYPE == 0 ? PC_QA : PC_QB) + h * 64, kcol = (TYPE == 0 ? PC_KA : PC_KB) + h * 64, vcol = (TYPE == 0 ? PC_VA : PC_VB) + h * 64;
    bf16* P = c.proj + (size_t)b * SEQ * NP;
    const int q0 = qb * 256, q0w = q0 + wid * 32, NT = (q0 + 256) / 64;
    LAS float* tab = (LAS float*)(lds + L_TAB);
    LAS float* wsf = (LAS float*)(lds + L_WSF) + wid * 128;
    float lam = 0.f, oscale = 1.f;
    if (TYPE == 0) {
        const f32x4* src = (const f32x4*)(c.biasA + h * 4096);
        for (int i = tid; i < 1024; i += 512) ((LAS f32x4*)tab)[i] = src[i];
        lam = c.lamv[layer]; oscale = 1.0f - (0.8f - 0.6f * expf(-0.3f * (float)layer));
    } else {
        const int n = q0 + 256, e0 = tid * 8;
        const f32x4* src = (const f32x4*)(c.logf + (size_t)(b * 8 + h) * SEQ) + 2 * tid;
        float v[8];
        if (e0 < n) { const f32x4 a = src[0], bb = src[1]; v[0] = a.x; v[1] = a.y; v[2] = a.z; v[3] = a.w; v[4] = bb.x; v[5] = bb.y; v[6] = bb.z; v[7] = bb.w; }
        else {
#pragma unroll
            for (int i = 0; i < 8; ++i) v[i] = 0.f; }
#pragma unroll
        for (int i = 1; i < 8; ++i) v[i] += v[i - 1];
        const float tot = v[7]; float sc = tot;
#pragma unroll
        for (int d = 1; d < 64; d <<= 1) { const float t = __shfl_up(sc, d); if (lane >= d) sc += t; }
        LAS float* wt = (LAS float*)(lds + L_SLOT + 64);
        if (lane == 63) wt[wid] = sc;
        __syncthreads();
        float woff = 0.f;
#pragma unroll
        for (int w = 0; w < 8; ++w) if (w < wid) woff += wt[w];
        const float base = woff + sc - tot;
        if (e0 < n) { f32x4 a, bb; a.x = base + v[0]; a.y = base + v[1]; a.z = base + v[2]; a.w = base + v[3]; bb.x = base + v[4]; bb.y = base + v[5]; bb.z = base + v[6]; bb.w = base + v[7];
            ((LAS f32x4*)tab)[2 * tid] = a; ((LAS f32x4*)tab)[2 * tid + 1] = bb; }
    }
    bf16x8 qf[4];
#pragma unroll
    for (int d0 = 0; d0 < 4; ++d0) qf[d0] = *(const bf16x8*)(P + (size_t)(q0w + r32) * NP + qcol + d0 * 16 + hi * 8);
    const int lkey = tid >> 3, lch = tid & 7;
    const bf16* kp = P + (size_t)lkey * NP + kcol + lch * 8; const bf16* vp = P + (size_t)lkey * NP + vcol + lch * 8;
    const int kwoff = lkey * 128 + ((lch ^ ((lkey >> 1) & 7)) * 16);
    const int vwoff = (lkey >> 5) * 4096 + (lch >> 2) * 2048 + ((lkey & 31) >> 4) * 1024 + ((lkey >> 3) & 1) * 512 + (lkey & 7) * 64 + (lch & 3) * 16;
    u32x4 kreg = *(const u32x4*)kp, vreg = *(const u32x4*)vp;
    *(LAS u32x4*)(lds + L_K + kwoff) = kreg; *(LAS u32x4*)(lds + L_V + vwoff) = vreg;
    kreg = *(const u32x4*)(kp + (size_t)64 * NP); vreg = *(const u32x4*)(vp + (size_t)64 * NP);
    __syncthreads();
    f32x16 oa0 = {}, oa1 = {}, ob0 = {}, ob1 = {};
    float ma = 0.f, mb = 0.f, la = 0.f, lb = 0.f;
    float cq = 0.f; if (TYPE == 1) cq = tab[q0w + r32];
    const int trb = (4 * hi + ((lane & 15) >> 2)) * 64 + ((lane >> 4) & 1) * 32 + (lane & 3) * 8;
    const int krd = r32 * 128, kx = (r32 >> 1) & 7;
    for (int t = 0; t < NT; ++t) {
        LAS const unsigned char* kb = lds + L_K + (t & 1) * 8192; LAS const unsigned char* vbuf = lds + L_V + (t & 1) * 8192;
#pragma unroll
        for (int hf = 0; hf < 2; ++hf) {
            const int k0 = t * 64 + hf * 32;
            if (k0 <= q0w + 31) {
                bf16x8 kf[4];
#pragma unroll
                for (int d0 = 0; d0 < 4; ++d0) kf[d0] = *(const LAS bf16x8*)(kb + hf * 4096 + krd + (((2 * d0 + hi) ^ kx) * 16));
                const bool diag = (k0 + 31 > q0w);
                const int dbase = q0w + r32 - k0;
                LAS const unsigned char* vb = vbuf + hf * 4096 + trb;
                if (TYPE == 0) {
                    f32x16 bs;
#pragma unroll
                    for (int r = 0; r < 16; ++r) { const int idx = dbase - crow(r, hi); float bv = tab[idx < 0 ? 0 : idx]; if (diag && idx < 0) bv = NEG_INF_F; bs[r] = bv; }
                    { f32x16 p;
#pragma unroll
                      for (int r = 0; r < 16; ++r) p[r] = -ma;
                      p = MFMA32(kf[0], qf[0], p); p = MFMA32(kf[1], qf[1], p); p += bs;
                      softmax_pv(p, oa0, oa1, ma, la, wsf, vb, r32, hi); }
                    __builtin_amdgcn_sched_barrier(0);
                    { f32x16 p;
#pragma unroll
                      for (int r = 0; r < 16; ++r) p[r] = -mb;
                      p = MFMA32(kf[2], qf[2], p); p = MFMA32(kf[3], qf[3], p); p += bs;
                      softmax_pv(p, ob0, ob1, mb, lb, wsf + 32, vb, r32, hi); }
                } else {
                    const float base = cq - ma;
                    f32x16 p;
#pragma unroll
                    for (int g = 0; g < 4; ++g) { const f32x4 ck = *(const LAS f32x4*)(tab + k0 + 8 * g + 4 * hi);
#pragma unroll
                        for (int e = 0; e < 4; ++e) p[4 * g + e] = base - ck[e]; }
#pragma unroll
                    for (int d0 = 0; d0 < 4; ++d0) p = MFMA32(kf[d0], qf[d0], p);
                    if (diag) {
#pragma unroll
                        for (int r = 0; r < 16; ++r) if (dbase - crow(r, hi) < 0) p[r] = NEG_INF_F; }
                    softmax_pv(p, oa0, oa1, ma, la, wsf, vb, r32, hi);
                }
            }
        }
        if (t + 1 < NT) { *(LAS u32x4*)(lds + L_K + ((t + 1) & 1) * 8192 + kwoff) = kreg; *(LAS u32x4*)(lds + L_V + ((t + 1) & 1) * 8192 + vwoff) = vreg; }
        __syncthreads();
        if (t + 2 < NT) { kreg = *(const u32x4*)(kp + (size_t)(t + 2) * 64 * NP); vreg = *(const u32x4*)(vp + (size_t)(t + 2) * 64 * NP); }
    }
    finish<TYPE>(oa0, oa1, ob0, ob1, la, lb, lam, oscale, c.diff_g + layer * 64, wsf, (LAS float*)(lds + L_STG + wid * 8192), P + (size_t)q0w * NP + qcol, (size_t)NP, lane, r32, hi);
}

DI void unit_c(const Ctx& c, int b, int h, int chunk, LAS unsigned char* lds) {
    const int tid = opaque_tid(), lane = tid & 63, wid = __builtin_amdgcn_readfirstlane(tid >> 6), r32 = lane & 31, hi = lane >> 5;
    bf16* P = c.proj + (size_t)b * SEQ * NP;
    LAS float* tabc = (LAS float*)(lds + L_TAB);
    for (int i = tid; i < 396; i += 512) tabc[i] = c.tabC[h * 396 + i];
    __syncthreads();
    LAS float* wsf = (LAS float*)(lds + L_WSF) + wid * 128;
    LAS unsigned char* vbuf = lds + L_K + wid * 4096;
    const int trb = (4 * hi + ((lane & 15) >> 2)) * 64 + ((lane >> 4) & 1) * 32 + (lane & 3) * 8;
    const int vw0 = ((lane & 7) >> 2) * 2048 + (lane >> 3) * 64 + (lane & 3) * 16;
    const int c0 = chunk * 512;
    for (int ci = 0; ci < 2; ++ci) {
        const int cls = wid + 8 * ci, tq = c0 + cls + 16 * r32, thi = c0 + cls + 496;
        f32x16 o0 = {}, o1 = {}; float mh = 0.f, l = 0.f;
#pragma unroll 1
        for (int g = 0; g < 3; ++g) {
            const int dl = g == 0 ? 1 : (g == 1 ? 4 : 16), NT = g == 0 ? 20 : (g == 1 ? 8 : 5), R = 16 / dl;
            const int qcol = (g == 0 ? PC_QC0 : (g == 1 ? PC_QC1 : PC_QC2)) + h * 64, kcol = PC_KC + 256 * g + h * 64, vcol = PC_VC + 256 * g + h * 64;
            bf16x8 qf[4];
#pragma unroll
            for (int d0 = 0; d0 < 4; ++d0) qf[d0] = *(const bf16x8*)(P + (size_t)tq * NP + qcol + d0 * 16 + hi * 8);
            const int tstart = thi - dl * (32 * NT - 1);
            bf16x8 kf[4]; u32x4 vr[4];
            { const int tk = tstart + dl * r32, tok = tk < 0 ? 0 : tk;
#pragma unroll
              for (int d0 = 0; d0 < 4; ++d0) kf[d0] = *(const bf16x8*)(P + (size_t)tok * NP + kcol + (2 * d0 + hi) * 8);
#pragma unroll
              for (int i = 0; i < 4; ++i) { const int tv = tstart + dl * ((lane >> 3) + 8 * i), tokv = tv < 0 ? 0 : tv; vr[i] = *(const u32x4*)(P + (size_t)tokv * NP + vcol + (lane & 7) * 8); } }
            for (int st = 0; st < NT; ++st) {
#pragma unroll
                for (int i = 0; i < 4; ++i) *(LAS u32x4*)(vbuf + vw0 + (i >> 1) * 1024 + (i & 1) * 512) = vr[i];
                bf16x8 kc[4];
#pragma unroll
                for (int d0 = 0; d0 < 4; ++d0) kc[d0] = kf[d0];
                if (st + 1 < NT) { const int j0 = 32 * (st + 1); const int tk = tstart + dl * (j0 + r32), tok = tk < 0 ? 0 : tk;
#pragma unroll
                    for (int d0 = 0; d0 < 4; ++d0) kf[d0] = *(const bf16x8*)(P + (size_t)tok * NP + kcol + (2 * d0 + hi) * 8);
#pragma unroll
                    for (int i = 0; i < 4; ++i) { const int tv = tstart + dl * (j0 + (lane >> 3) + 8 * i), tokv = tv < 0 ? 0 : tv; vr[i] = *(const u32x4*)(P + (size_t)tokv * NP + vcol + (lane & 7) * 8); } }
                LDS_WAIT();
                f32x16 p;
#pragma unroll
                for (int r = 0; r < 16; ++r) p[r] = -mh;
#pragma unroll
                for (int d0 = 0; d0 < 4; ++d0) p = MFMA32(kc[d0], qf[d0], p);
                const int nb = R * (r32 - 31) + 32 * NT - 1 - 32 * st;
#pragma unroll
                for (int r = 0; r < 16; ++r) { const int n = nb - crow(r, hi); const bool valid = ((unsigned)n <= 128u) && (tq - dl * n >= 0);
                    const int nc = n < 0 ? 0 : (n > 128 ? 128 : n); const float bv = tabc[g * 132 + nc]; p[r] = valid ? p[r] + bv : NEG_INF_F; }
                softmax_pv(p, o0, o1, mh, l, wsf, vbuf + trb, r32, hi);
                LDS_WAIT();
            }
        }
        finish<2>(o0, o1, o0, o1, l, l, 0.f, 1.f, nullptr, wsf, (LAS float*)(lds + L_STG + wid * 8192), P + (size_t)(c0 + cls) * NP + PC_QC2 + h * 64, (size_t)16 * NP, lane, r32, hi);
    }
}

DI void attn_phase(const Ctx& c, int layer, LAS unsigned char* lds) {
    LAS int* slot = (LAS int*)(lds + L_SLOT);
    unsigned* counter = c.ctl + 64 * layer; const int tid0 = opaque_tid();
    for (;;) {
        __syncthreads();
        if (tid0 == 0) slot[0] = (int)atomicAdd(counter, 1u);
        __syncthreads();
        const int u = __builtin_amdgcn_readfirstlane(slot[0]);
        if (u >= N_UNITS) break;
#ifndef NO_UC
        if (u < 256) { unit_c(c, u >> 5, (u >> 3) & 3, u & 7, lds); } else
#endif
        { const int v = u - 256, lev = 15 - v / 96, r = v % 96;
#ifndef NO_UA
            if (r < 32) unit_ab<0>(c, layer, r >> 2, r & 3, lev, lds); else
#endif
#ifndef NO_UB
            unit_ab<1>(c, layer, (r - 32) >> 3, (r - 32) & 7, lev, lds);
#endif
            (void)lev; (void)r; }
    }
}
}

constexpr int LDS_BYTES = 131072 + 1024;
constexpr int N_PHASES = 2 + 5 * DEPTH;
struct Args { const float* in[15]; float* out; unsigned char* ws; int ph_lo, ph_hi; };
typedef const __attribute__((address_space(4))) Args* KArgP;
DI Ctx make_ctx(KArgP a) {
    Ctx c;
    c.x = a->in[0]; c.norm1_g = a->in[1]; c.w_in = a->in[2]; c.b_f = a->in[3]; c.lam_q1 = a->in[4]; c.lam_k1 = a->in[5]; c.lam_q2 = a->in[6]; c.lam_k2 = a->in[7]; c.diff_g = a->in[8];
    c.w_o = a->in[9]; c.norm2_g = a->in[10]; c.w_1 = a->in[11]; c.w_2 = a->in[12]; c.rel_bias = a->in[13]; c.final_g = a->in[14];
    c.out = a->out; c.ws = a->ws; unsigned char* ws = a->ws;
    c.win_t = (bf16*)(ws + WS_WIN); c.wo_t = (bf16*)(ws + WS_WO); c.w1_t = (bf16*)(ws + WS_W1); c.w2_t = (bf16*)(ws + WS_W2);
    c.xn = (bf16*)(ws + WS_XN); c.proj = (bf16*)(ws + WS_PROJ);
    c.ss = (unsigned long long*)(ws + WS_SS); c.logf = (float*)(ws + WS_LOGF); c.biasA = (float*)(ws + WS_BIASA); c.tabC = (float*)(ws + WS_TABC); c.lamv = (float*)(ws + WS_TABC + 8192); c.ctl = (unsigned*)(ws + WS_CTL);
    return c;
}
#define PHASE_CTX() KArgP ap_ = (KArgP)__builtin_amdgcn_kernarg_segment_ptr(); asm volatile("" : "+s"(ap_)); const Ctx c = make_ctx(ap_)
__global__ void __launch_bounds__(512, 2) trunk_fwd(Args a) {
    extern __shared__ __attribute__((aligned(16))) unsigned char lds_raw[];
    LAS unsigned char* lds = (LAS unsigned char*)lds_raw;
    cg::grid_group grid = cg::this_grid();
#ifdef FORCE_LO
    const int lo = FORCE_LO, hi = FORCE_HI, G = gridDim.x;
#else
    const int lo = a.ph_lo, hi = a.ph_hi, G = gridDim.x;
#endif
#define RUN(p) (lo <= (p) && (p) < hi)
#define SEAM(p) do { if (RUN(p) && RUN((p) + 1)) grid.sync(); } while (0)
    if (RUN(0)) { PHASE_CTX(); p0_prologue(c, lds); }
    SEAM(0);
    for (int l = 0; l < DEPTH; ++l) {
        const int pb = 1 + 5 * l;
        if (RUN(pb)) { PHASE_CTX();
            pg8::Gemm g{c.xn, c.win_t + (size_t)l * NP * DM, MTOK, NP, DM, DM}; pg8::StaticOrder S; S.init(MTOK, NP, G, opaque_bid());
            pg8::EpiScaleBf16<0> E{c.proj, NP, c.ss + (size_t)(2 * l) * MTOK};
            pg8::gemm_phase<pg8::EpiScaleBf16<0>, pg8::StaticOrder, true, true>(lds, g, S, E);
            { PHASE_CTX(); fgate_phase(c, l, lds); }
        }
        SEAM(pb);
        if (RUN(pb + 1)) { PHASE_CTX(); att::attn_phase(c, l, lds); }
        SEAM(pb + 1);
        if (RUN(pb + 2)) { PHASE_CTX();
            pg8::Gemm g{c.proj, c.wo_t + (size_t)l * DM * DM, MTOK, DM, DM, NP}; pg8::StaticOrder S; S.init(MTOK, DM, G, opaque_bid());
            pg8::EpiRes E{c.out, c.xn, c.ss + (size_t)(2 * l + 1) * MTOK};
            pg8::gemm_phase<pg8::EpiRes, pg8::StaticOrder, true, true>(lds, g, S, E);
        }
        SEAM(pb + 2);
        if (RUN(pb + 3)) { PHASE_CTX();
            pg8::Gemm g{c.xn, c.w1_t + (size_t)l * FF * DM, MTOK, FF, DM, DM}; pg8::StaticOrder S; S.init(MTOK, FF, G, opaque_bid());
            pg8::EpiScaleBf16<1> E{c.proj, FF, c.ss + (size_t)(2 * l + 1) * MTOK};
            pg8::gemm_phase<pg8::EpiScaleBf16<1>, pg8::StaticOrder, true, true>(lds, g, S, E);
        }
        SEAM(pb + 3);
        if (RUN(pb + 4)) { PHASE_CTX();
            pg8::Gemm g{c.proj, c.w2_t + (size_t)l * DM * FF, MTOK, DM, FF, FF}; pg8::StaticOrder S; S.init(MTOK, DM, G, opaque_bid());
            pg8::EpiRes E{c.out, c.xn, c.ss + (size_t)(2 * l + 2) * MTOK};
            pg8::gemm_phase<pg8::EpiRes, pg8::StaticOrder, true, true>(lds, g, S, E);
        }
        SEAM(pb + 4);
    }
    if (RUN(N_PHASES - 1)) { PHASE_CTX(); final_phase(c); }
#undef RUN
#undef SEAM
}

#ifndef MK_PER_PHASE
#define MK_PER_PHASE 0
#endif
extern "C" void kernel_launch(void* const* d_in, const int* in_sizes, int n_in, void* d_out, int out_size, void* d_ws, size_t ws_size, hipStream_t stream) {
    static int grid = 0;
    if (grid == 0) {
        if (n_in != 15 || out_size != MTOK * DM || ws_size < WS_END) { fprintf(stderr, "kernel_launch: unexpected sizes n_in %d out %d ws %zu (need %zu)\n", n_in, out_size, ws_size, (size_t)WS_END); grid = -1; return; }
        int dev = 0, cus = 0, per_cu = 0;
        (void)hipGetDevice(&dev); (void)hipDeviceGetAttribute(&cus, hipDeviceAttributeMultiprocessorCount, dev);
        if (hipFuncSetAttribute((const void*)trunk_fwd, hipFuncAttributeMaxDynamicSharedMemorySize, LDS_BYTES) != hipSuccess) { fprintf(stderr, "kernel_launch: hipFuncSetAttribute failed\n"); grid = -1; return; }
        if (hipOccupancyMaxActiveBlocksPerMultiprocessor(&per_cu, (const void*)trunk_fwd, 512, LDS_BYTES) != hipSuccess || per_cu < 1) { fprintf(stderr, "kernel_launch: occupancy query says %d\n", per_cu); per_cu = 1; }
        (void)hipGetLastError();
        grid = cus > 0 ? cus : 256;
        fprintf(stderr, "kernel_launch: grid %d (cus %d, per_cu %d)\n", grid, cus, per_cu);
    }
    if (grid < 0) return;
    Args a{};
    for (int i = 0; i < 15; ++i) a.in[i] = (const float*)d_in[i];
    a.out = (float*)d_out; a.ws = (unsigned char*)d_ws;
#if MK_PER_PHASE
    for (int p = 0; p < N_PHASES; ++p) { a.ph_lo = p; a.ph_hi = p + 1; hipLaunchKernelGGL(trunk_fwd, dim3(grid), dim3(512), LDS_BYTES, stream, a); }
#else
    a.ph_lo = 0; a.ph_hi = N_PHASES;
    void* args[] = {&a};
    hipError_t e = hipLaunchCooperativeKernel((const void*)trunk_fwd, dim3(grid), dim3(512), args, LDS_BYTES, stream);
    if (e != hipSuccess) fprintf(stderr, "kernel_launch: cooperative launch failed: %s (grid %d)\n", hipGetErrorString(e), grid);
#endif
}
```

```cpp
#include <hip/hip_runtime.h>
#include <hip/hip_cooperative_groups.h>
#include <cstdio>
#include <cstdint>
#include <cmath>
namespace cg = cooperative_groups;

constexpr int NBATCH = 8, SEQ = 4096, DM = 1024, DEPTH = 4, FF = 4096;
constexpr int MTOK = NBATCH * SEQ;
constexpr int NIN = 4616;
constexpr int NP = 4608;
constexpr int F_OFF = 2304;
constexpr float NORM_EPS = 1e-6f;
constexpr float LOG2E = 1.4426950408889634f;
constexpr int PC_QA = 0, PC_QB = 256, PC_QC2 = 768, PC_QC0 = 1024, PC_QC1 = 1280, PC_KA = 1536, PC_VA = 1792, PC_KB = 2048, PC_VB = 2560, PC_KC = 3072, PC_VC = 3840;

constexpr size_t MiB = 1u << 20;
constexpr size_t WS_CTL = 0;
constexpr size_t WS_SS = 64 * 1024;
constexpr size_t WS_LOGF = 3 * MiB;
constexpr size_t WS_BIASA = 4 * MiB;
constexpr size_t WS_TABC = 4 * MiB + 64 * 1024;
constexpr size_t WS_WIN = 8 * MiB, WS_WO = 44 * MiB, WS_W1 = 52 * MiB, WS_W2 = 84 * MiB;
constexpr size_t WS_XN = 116 * MiB;
constexpr size_t WS_PROJ = 180 * MiB;
constexpr size_t WS_END = 468 * MiB;
constexpr float SS_SCALE = 16777216.0f, SS_INV = 1.0f / 16777216.0f;

#define DI __device__ __forceinline__
#define LAS __attribute__((address_space(3)))
typedef float f32x16 __attribute__((ext_vector_type(16)));
typedef short s16x4 __attribute__((ext_vector_type(4)));
typedef unsigned u32x2 __attribute__((ext_vector_type(2)));
#define LDS_WAIT() asm volatile("s_waitcnt lgkmcnt(0)" ::: "memory")
DI int opaque_tid() { int t = threadIdx.x; asm volatile("" : "+v"(t)); return t; }
DI int opaque_bid() { int b = blockIdx.x; asm volatile("" : "+s"(b)); return b; }

namespace pg8 {
#define PG8_LAS __attribute__((address_space(3)))
typedef unsigned short bf16_t;
typedef short bf16x8 __attribute__((ext_vector_type(8)));
typedef float f32x4 __attribute__((ext_vector_type(4)));
typedef unsigned u32x4 __attribute__((ext_vector_type(4)));
constexpr int BM = 256, BK = 64, HALF = 128, HTB = HALF * BK * 2  , STAGE_BYTES = 8 * HTB, NXCD = 8, WGM = 4;

__host__ __device__ __forceinline__ int lds_byte(int r, int c) { const int st = (r >> 4) * 2 + (c >> 5), rr = r & 15, cc = c & 31, ob = rr * 64 + cc * 2; return st * 1024 + (ob ^ (((ob >> 9) & 1) << 5)); }
__host__ __device__ __forceinline__ void stage_rc(int b, int& R, int& C) { const int st = b / 1024, sb = b % 1024, swz = sb ^ (((sb >> 9) & 1) << 5); R = (st >> 1) * 16 + swz / 64; C = (st & 1) * 32 + (swz % 64) / 2; }
__host__ __device__ __forceinline__ int perm32(int rho) { const int n = rho >> 4, i = rho & 15; return 8 * (i >> 2) + 4 * n + (i & 3); }

struct Unit { int pm, pn; };
struct Gemm { const bf16_t* A; const bf16_t* Bt; int M, N, K, lda; };

struct StaticOrder {
    int nM, nN, nwg, G, c;
    __host__ __device__ void init(int M, int N, int G_, int c_) { nM = M / BM; nN = N / BM; nwg = nM * nN; G = G_; c = c_; }
    __host__ __device__ bool next(int i, Unit& u) const {
        const long L = (long)i * G + c; if (L >= nwg) return false;
        int wgid = (int)L; { const int q = nwg / NXCD, r = nwg % NXCD, xcd = wgid % NXCD, off = wgid / NXCD; wgid = (xcd < r ? xcd * (q + 1) : r * (q + 1) + (xcd - r) * q) + off; }
        const int nig = WGM * nN, gid = wgid / nig, fm = gid * WGM, gsz = (nM - fm) < WGM ? (nM - fm) : WGM;
        u.pm = fm + ((wgid % nig) % gsz); u.pn = (wgid % nig) / gsz; return true;
    }
    __device__ __forceinline__ void a_ready(const Unit&) const {}
    __device__ __forceinline__ void done(const Unit&) const {}
};

__device__ __forceinline__ unsigned cvt_pk_bf16(float lo, float hi) { unsigned r; asm volatile("v_cvt_pk_bf16_f32 %0, %1, %2" : "=v"(r) : "v"(lo), "v"(hi)); return r; }
typedef float f32x2 __attribute__((ext_vector_type(2)));
__device__ __forceinline__ float row_rs(const unsigned long long* ss, int row) { return 1.0f / sqrtf((float)ss[row] * (SS_INV / 1024.0f) + NORM_EPS); }
template <int MODE> struct EpiScaleBf16 {
    static constexpr bool PERM = true, AFTER_DRAIN = false;
    bf16_t* O; int ldc; const unsigned long long* ss;
    __device__ __forceinline__ void operator()(const f32x4 (&acc)[2][2][4][2], const Unit& u, int wr, int wc, int fr, int fq) const {
        const int row0 = u.pm * BM + wr * 64 + fr, col0 = u.pn * BM + wc * 32 + 8 * fq;
        float sc = 1.f;
        if (MODE == 0) { if (u.pn == 0) sc = 0.17677669529663687f * LOG2E; else if (u.pn < 6) sc = 0.125f * LOG2E; }
        unsigned long long ssv[2][4];
#pragma unroll
        for (int ai = 0; ai < 2; ++ai)
#pragma unroll
            for (int m = 0; m < 4; ++m) ssv[ai][m] = ss[row0 + ai * HALF + m * 16];
#pragma unroll
        for (int ai = 0; ai < 2; ++ai)
#pragma unroll
            for (int m = 0; m < 4; ++m) { const int row = row0 + ai * HALF + m * 16; const float rs = sc / sqrtf((float)ssv[ai][m] * (SS_INV / 1024.0f) + NORM_EPS); bf16_t* rowp = O + (size_t)row * ldc + col0;
#pragma unroll
                for (int bj = 0; bj < 2; ++bj) { f32x4 v0 = acc[ai][bj][m][0] * rs, v1 = acc[ai][bj][m][1] * rs;
                    if (MODE == 1) {
#pragma unroll
                        for (int e = 0; e < 4; ++e) { const float a = fmaxf(v0[e], 0.f), b = fmaxf(v1[e], 0.f); v0[e] = a * a; v1[e] = b * b; } }
                    u32x4 w; w.x = cvt_pk_bf16(v0[0], v0[1]); w.y = cvt_pk_bf16(v0[2], v0[3]); w.z = cvt_pk_bf16(v1[0], v1[1]); w.w = cvt_pk_bf16(v1[2], v1[3]);
                    *(u32x4*)(rowp + bj * HALF) = w; } }
    }
};
struct EpiRes {
    static constexpr bool PERM = true, AFTER_DRAIN = false;
    bf16_t* XN; unsigned long long* ssout;
    __device__ __forceinline__ void operator()(const f32x4 (&acc)[2][2][4][2], const Unit& u, int wr, int wc, int fr, int fq) const {
        const int row0 = u.pm * BM + wr * 64 + fr, col0 = u.pn * BM + wc * 32 + 8 * fq;
#pragma unroll
        for (int ai = 0; ai < 2; ++ai) {
            u32x4 pre[4][2];
#pragma unroll
            for (int m = 0; m < 4; ++m)
#pragma unroll
                for (int bj = 0; bj < 2; ++bj) pre[m][bj] = *(const u32x4*)(XN + (size_t)(row0 + ai * HALF + m * 16) * DM + col0 + bj * HALF);
            asm volatile("" ::: "memory");
#pragma unroll
            for (int m = 0; m < 4; ++m) { const int row = row0 + ai * HALF + m * 16; float s = 0.f;
#pragma unroll
                for (int bj = 0; bj < 2; ++bj) { const u32x4 o = pre[m][bj]; const f32x4 a0 = acc[ai][bj][m][0], a1 = acc[ai][bj][m][1];
                    float x[8];
                    x[0] = __uint_as_float(o.x << 16) + a0[0]; x[1] = __uint_as_float(o.x & 0xffff0000u) + a0[1]; x[2] = __uint_as_float(o.y << 16) + a0[2]; x[3] = __uint_as_float(o.y & 0xffff0000u) + a0[3];
                    x[4] = __uint_as_float(o.z << 16) + a1[0]; x[5] = __uint_as_float(o.z & 0xffff0000u) + a1[1]; x[6] = __uint_as_float(o.w << 16) + a1[2]; x[7] = __uint_as_float(o.w & 0xffff0000u) + a1[3];
#pragma unroll
                    for (int e = 0; e < 8; ++e) s += x[e] * x[e];
                    u32x4 w; w.x = cvt_pk_bf16(x[0], x[1]); w.y = cvt_pk_bf16(x[2], x[3]); w.z = cvt_pk_bf16(x[4], x[5]); w.w = cvt_pk_bf16(x[6], x[7]);
                    *(u32x4*)(XN + (size_t)row * DM + col0 + bj * HALF) = w; }
                s += __shfl_xor(s, 16); s += __shfl_xor(s, 32);
                if (fq == 0) atomicAdd(ssout + row, (unsigned long long)(s * SS_SCALE)); }
        }
    }
};

template <class Epi, class Sched, bool ALIGN_EPI = false, bool SP2 = false>
__device__ __forceinline__ void gemm_phase(PG8_LAS unsigned char* lds, const Gemm g, const Sched& S, const Epi& E) {
    const int tid = opaque_tid(), wid = __builtin_amdgcn_readfirstlane(tid >> 6), lane = tid & 63, wr = wid >> 2, wc = wid & 3, fr = lane & 15, fq = lane >> 4;
    const int K = g.K, nt = K / BK;
    unsigned voffA[2], voffB[2];
#pragma unroll
    for (int i = 0; i < 2; ++i) { int R, C; stage_rc(tid * 16 + i * 8192, R, C); const int Rb = Epi::PERM ? ((R & ~31) + perm32(R & 31)) : R;
        voffA[i] = (unsigned)(R * g.lda + C) * 2u; voffB[i] = (unsigned)(Rb * K + C) * 2u; }
    const size_t kstep = (size_t)(BK * 2);
    const size_t hstepA = (size_t)HALF * g.lda * 2, hstepB = (size_t)HALF * K * 2;
    const size_t tstepA = 2 * hstepA, tstepB = 2 * hstepB;
    const unsigned ldsw = (unsigned)wid * 1024u;
    const int aoff = lds_byte(wr * 64 + fr, fq * 8), boff = lds_byte(wc * 32 + fr, fq * 8);
#define PG8_SA(b, h) (((b) * 2 + (h)) * HTB)
#define PG8_SB(b, h) ((4 + (b) * 2 + (h)) * HTB)
#define PG8_STAGE(bufoff, gbase, voff) do { _Pragma("unroll") for (int _i = 0; _i < 2; ++_i) \
        __builtin_amdgcn_global_load_lds((const unsigned*)((const char*)(gbase) + (voff)[_i]), (PG8_LAS unsigned*)(lds + (bufoff) + ldsw + _i * 8192), 16, 0, 0); } while (0)
#define PG8_LDA(dst, b, h) do { _Pragma("unroll") for (int m = 0; m < 4; ++m) _Pragma("unroll") for (int k = 0; k < 2; ++k) dst[m][k] = *(const PG8_LAS bf16x8*)(lds + PG8_SA(b, h) + aoff + m * 2048 + k * 1024); } while (0)
#define PG8_LDB(dst, b, h) do { _Pragma("unroll") for (int n = 0; n < 2; ++n) _Pragma("unroll") for (int k = 0; k < 2; ++k) dst[n][k] = *(const PG8_LAS bf16x8*)(lds + PG8_SB(b, h) + boff + n * 2048 + k * 1024); } while (0)
#define PG8_MMA(ai, bj, At, Bt) do { __builtin_amdgcn_s_setprio(1); _Pragma("unroll") for (int m = 0; m < 4; ++m) _Pragma("unroll") for (int n = 0; n < 2; ++n) _Pragma("unroll") for (int k = 0; k < 2; ++k) \
        acc[ai][bj][m][n] = __builtin_amdgcn_mfma_f32_16x16x32_bf16(Bt[n][k], At[m][k], acc[ai][bj][m][n], 0, 0, 0); __builtin_amdgcn_s_setprio(0); } while (0)
#define PG8_WAIT_V(n) asm volatile("s_waitcnt vmcnt(" #n ")" ::: "memory")
#define PG8_WAIT_L(n) asm volatile("s_waitcnt lgkmcnt(" #n ")" ::: "memory")
#define PG8_BAR __builtin_amdgcn_s_barrier()
#define PG8_SCHED __builtin_amdgcn_sched_barrier(0)
    Unit cur, nxt; int ui = 0;
    if (!S.next(0, cur)) return;
    f32x4 acc[2][2][4][2];
#pragma unroll
    for (int a = 0; a < 2; ++a)
#pragma unroll
        for (int b = 0; b < 2; ++b)
#pragma unroll
            for (int m = 0; m < 4; ++m)
#pragma unroll
                for (int n = 0; n < 2; ++n) acc[a][b][m][n] = (f32x4){0.f, 0.f, 0.f, 0.f};
    bf16x8 At[4][2], B0[2][2], B1[2][2];
    const char* cA = (const char*)g.A + (size_t)cur.pm * tstepA; const char* cB = (const char*)g.Bt + (size_t)cur.pn * tstepB;
    S.a_ready(cur);
    if constexpr (SP2) {
        PG8_STAGE(PG8_SB(0, 0), cB, voffB); PG8_STAGE(PG8_SB(0, 1), cB + hstepB, voffB); PG8_STAGE(PG8_SA(0, 0), cA, voffA); PG8_STAGE(PG8_SA(0, 1), cA + hstepA, voffA);
        if (wr == 1) PG8_BAR;
        PG8_WAIT_V(2); PG8_BAR;
        PG8_STAGE(PG8_SB(1, 0), cB + kstep, voffB); PG8_STAGE(PG8_SA(1, 0), cA + kstep, voffA); PG8_STAGE(PG8_SB(1, 1), cB + hstepB + kstep, voffB);
        PG8_WAIT_V(6); PG8_BAR;
    } else {
        PG8_STAGE(PG8_SB(0, 0), cB, voffB); PG8_STAGE(PG8_SA(0, 0), cA, voffA); PG8_STAGE(PG8_SB(0, 1), cB + hstepB, voffB); PG8_STAGE(PG8_SA(0, 1), cA + hstepA, voffA);
        if (wr == 1) PG8_BAR;
        PG8_WAIT_V(4); PG8_BAR;
        PG8_STAGE(PG8_SB(1, 0), cB + kstep, voffB); PG8_STAGE(PG8_SA(1, 0), cA + kstep, voffA); PG8_STAGE(PG8_SB(1, 1), cB + hstepB + kstep, voffB);
        PG8_WAIT_V(6); PG8_BAR;
    }
    for (;;) {
        const bool has_next = S.next(ui + 1, nxt);
        const char* nA = has_next ? (const char*)g.A + (size_t)nxt.pm * tstepA : cA; const char* nB = has_next ? (const char*)g.Bt + (size_t)nxt.pn * tstepB : cB;
        for (int t = 0; t < nt; t += 2) {
            const bool last = (t == nt - 2);
            const char* a1 = cA + (size_t)(t + 1) * kstep;
            const char* a2 = last ? nA : cA + (size_t)(t + 2) * kstep; const char* b2 = last ? nB : cB + (size_t)(t + 2) * kstep;
            const char* a3 = a2 + kstep; const char* b3 = b2 + kstep;
            if (last && has_next) S.a_ready(nxt);
            if constexpr (SP2) {
            PG8_LDB(B0, 0, 0); PG8_LDB(B1, 0, 1); PG8_SCHED; PG8_LDA(At, 0, 0); PG8_STAGE(PG8_SA(1, 1), a1 + hstepA, voffA);
            PG8_WAIT_V(8); PG8_WAIT_L(0); PG8_BAR; PG8_MMA(0, 0, At, B0); PG8_MMA(0, 1, At, B1); PG8_BAR; PG8_SCHED;
            PG8_LDA(At, 0, 1); PG8_STAGE(PG8_SB(0, 0), b2, voffB); PG8_STAGE(PG8_SB(0, 1), b2 + hstepB, voffB); PG8_STAGE(PG8_SA(0, 0), a2, voffA);
            PG8_WAIT_V(8); PG8_WAIT_L(0); PG8_BAR; PG8_MMA(1, 0, At, B0); PG8_MMA(1, 1, At, B1); PG8_BAR; PG8_SCHED;
            PG8_LDB(B0, 1, 0); PG8_LDB(B1, 1, 1); PG8_SCHED; PG8_LDA(At, 1, 0); PG8_STAGE(PG8_SA(0, 1), a2 + hstepA, voffA);
            PG8_WAIT_V(8); PG8_WAIT_L(0); PG8_BAR; PG8_MMA(0, 0, At, B0); PG8_MMA(0, 1, At, B1); PG8_BAR; PG8_SCHED;
            PG8_LDA(At, 1, 1); PG8_STAGE(PG8_SB(1, 0), b3, voffB); PG8_STAGE(PG8_SB(1, 1), b3 + hstepB, voffB); PG8_STAGE(PG8_SA(1, 0), a3, voffA);
            PG8_WAIT_V(8); PG8_WAIT_L(0); PG8_BAR; PG8_MMA(1, 0, At, B0); PG8_MMA(1, 1, At, B1); PG8_BAR; PG8_SCHED;
            } else {
            PG8_LDB(B0, 0, 0); PG8_SCHED; PG8_LDA(At, 0, 0); PG8_STAGE(PG8_SA(1, 1), a1 + hstepA, voffA);
            PG8_WAIT_L(8); PG8_BAR; PG8_WAIT_L(0); PG8_MMA(0, 0, At, B0); PG8_BAR; PG8_SCHED;
            PG8_LDB(B1, 0, 1); PG8_STAGE(PG8_SB(0, 0), b2, voffB);
            PG8_BAR; PG8_WAIT_L(0); PG8_MMA(0, 1, At, B1); PG8_BAR;
            PG8_LDA(At, 0, 1); PG8_STAGE(PG8_SA(0, 0), a2, voffA);
            PG8_BAR; PG8_WAIT_L(0); PG8_MMA(1, 0, At, B0); PG8_BAR; PG8_SCHED;
            PG8_STAGE(PG8_SB(0, 1), b2 + hstepB, voffB);
            PG8_WAIT_V(6); PG8_BAR; PG8_MMA(1, 1, At, B1); PG8_BAR;
            PG8_LDB(B0, 1, 0); PG8_SCHED; PG8_LDA(At, 1, 0); PG8_STAGE(PG8_SA(0, 1), a2 + hstepA, voffA);
            PG8_WAIT_L(8); PG8_BAR; PG8_WAIT_L(0); PG8_MMA(0, 0, At, B0); PG8_BAR; PG8_SCHED;
            PG8_LDB(B1, 1, 1); PG8_STAGE(PG8_SB(1, 0), b3, voffB);
            PG8_BAR; PG8_WAIT_L(0); PG8_MMA(0, 1, At, B1); PG8_BAR;
            PG8_LDA(At, 1, 1); PG8_STAGE(PG8_SA(1, 0), a3, voffA);
            PG8_BAR; PG8_WAIT_L(0); PG8_MMA(1, 0, At, B0); PG8_BAR; PG8_SCHED;
            PG8_STAGE(PG8_SB(1, 1), b3 + hstepB, voffB);
            PG8_WAIT_V(6); PG8_BAR; PG8_MMA(1, 1, At, B1); PG8_BAR;
            }
        }
        if constexpr (ALIGN_EPI) { if (wr == 0) PG8_BAR; }
        if constexpr (!Epi::AFTER_DRAIN) { E(acc, cur, wr, wc, fr, fq); S.done(cur); }
        if (!has_next) break;
#pragma unroll
        for (int a = 0; a < 2; ++a)
#pragma unroll
            for (int b = 0; b < 2; ++b)
#pragma unroll
                for (int m = 0; m < 4; ++m)
#pragma unroll
                    for (int n = 0; n < 2; ++n) acc[a][b][m][n] = (f32x4){0.f, 0.f, 0.f, 0.f};
        cur = nxt; cA = nA; cB = nB; ++ui;
        if constexpr (ALIGN_EPI) { if (wr == 1) PG8_BAR; }
    }
    PG8_WAIT_V(0);
    if constexpr (!ALIGN_EPI) { if (wr == 0) PG8_BAR; }
    PG8_BAR;
    if constexpr (Epi::AFTER_DRAIN) { E.fused(acc, cur, wr, wc, fr, fq, lds, wid, lane); S.done(cur); }
#undef PG8_SA
#undef PG8_SB
#undef PG8_STAGE
#undef PG8_LDA
#undef PG8_LDB
#undef PG8_MMA
#undef PG8_WAIT_V
#undef PG8_WAIT_L
#undef PG8_BAR
#undef PG8_SCHED
}
}
typedef unsigned short bf16;
typedef float f32x4 __attribute__((ext_vector_type(4)));
typedef short bf16x8 __attribute__((ext_vector_type(8)));
typedef unsigned u32x4 __attribute__((ext_vector_type(4)));
typedef short v4i16_t __attribute__((ext_vector_type(4)));
typedef float f32x2_t __attribute__((ext_vector_type(2)));
typedef __bf16 bf16x2_t __attribute__((ext_vector_type(2)));
DI unsigned cvtpk(float lo, float hi) { f32x2_t v = {lo, hi}; bf16x2_t b = __builtin_convertvector(v, bf16x2_t); return __builtin_bit_cast(unsigned, b); }
DI float bf2f(unsigned short u) { return __uint_as_float((unsigned)u << 16); }
DI float wave_sum(float v) {
#pragma unroll
    for (int o = 1; o < 64; o <<= 1) v += __shfl_xor(v, o);
    return v;
}
struct Ctx {
    const float *x, *norm1_g, *w_in, *b_f, *lam_q1, *lam_k1, *lam_q2, *lam_k2, *diff_g, *w_o, *norm2_g, *w_1, *w_2, *rel_bias, *final_g;
    float* out; unsigned char* ws;
    bf16 *win_t, *wo_t, *w1_t, *w2_t, *xn, *proj;
    unsigned long long* ss; float* logf; float* biasA; float* tabC; float* lamv; float* knorm; unsigned* knA; unsigned* ctl;
};

DI int colmap(int t) {
    switch (t) { case 0: return 0; case 1: return 768; case 2: return 1024; case 3: return 2824; case 4: return 2312; case 5: return 2568; case 6: return 256; case 7: return 512;
                 case 8: return 1280; case 9: return 1536; case 10: return 1792; case 11: return 2048; case 12: return 3080; case 13: return 3336; case 14: return 3592;
                 case 15: return 3848; case 16: return 4104; default: return 4360; }
}
DI void p0_transpose_item(const float* W, int ldw, int n0src, int k0, const float* g, bf16* WT, int K, int nrow0, LAS float* scr, int lane) {
#pragma unroll 8
    for (int i = 0; i < 32; ++i) { const int kk = 2 * i + (lane >> 5); float v = W[(size_t)(k0 + kk) * ldw + n0src + (lane & 31)]; if (g) v *= g[k0 + kk]; scr[kk * 33 + (lane & 31)] = v; }
    LDS_WAIT();
    const int c = lane & 7;
#pragma unroll
    for (int j = 0; j < 4; ++j) { const int n = (lane >> 3) + 8 * j; const LAS float* s = scr + (8 * c) * 33 + n;
        u32x4 o; o.x = cvtpk(s[0 * 33], s[1 * 33]); o.y = cvtpk(s[2 * 33], s[3 * 33]); o.z = cvtpk(s[4 * 33], s[5 * 33]); o.w = cvtpk(s[6 * 33], s[7 * 33]);
        *(u32x4*)(WT + (size_t)(nrow0 + n) * K + k0 + 8 * c) = o; }
    LDS_WAIT();
}
DI int t5_bucket(int d) {
    if (d < 16) return d;
    int lg = 16 + (int)(logf((float)d / 16.0f) / 4.852030263919617f * 16.0f);
    return lg < 31 ? lg : 31;
}
constexpr int P0_I_IN = 16 * 144, P0_I_O = 16 * 32, P0_I_1 = 16 * 128, P0_I_2 = 64 * 32, P0_I_L = P0_I_IN + P0_I_O + P0_I_1 + P0_I_2;
DI void p0_conv_item(const Ctx& c, int l, int r, LAS float* scr, int lane) {
    if (r < P0_I_IN) { const int kb = r / 144, nb = r - kb * 144, np0 = nb * 32;
        p0_transpose_item(c.w_in + (size_t)l * DM * NIN, NIN, colmap(np0 >> 8) + (np0 & 255), kb * 64, c.norm1_g + l * DM, c.win_t + (size_t)l * NP * DM, DM, np0, scr, lane); return; }
    r -= P0_I_IN;
    if (r < P0_I_O) { const int kb = r / 32, nb = r - kb * 32;
        p0_transpose_item(c.w_o + (size_t)l * DM * DM, DM, nb * 32, kb * 64, nullptr, c.wo_t + (size_t)l * DM * DM, DM, nb * 32, scr, lane); return; }
    r -= P0_I_O;
    if (r < P0_I_1) { const int kb = r / 128, nb = r - kb * 128;
        p0_transpose_item(c.w_1 + (size_t)l * DM * FF, FF, nb * 32, kb * 64, c.norm2_g + l * DM, c.w1_t + (size_t)l * FF * DM, DM, nb * 32, scr, lane); return; }
    r -= P0_I_1;
    { const int kb = r / 32, nb = r - kb * 32;
        p0_transpose_item(c.w_2 + (size_t)l * FF * DM, DM, nb * 32, kb * 64, nullptr, c.w2_t + (size_t)l * DM * FF, FF, nb * 32, scr, lane); }
}
DI void p0_prologue(const Ctx& c, LAS unsigned char* lds) {
    const int tid = opaque_tid(), lane = tid & 63, wave = __builtin_amdgcn_readfirstlane(tid >> 6);
    const int G = gridDim.x, bid = opaque_bid(), gw = bid * 8 + wave, NGW = G * 8, gt = bid * 512 + tid, NGT = G * 512;
    LAS float* scr = (LAS float*)(lds + wave * 16384);
    for (int it = gw; it < P0_I_L; it += NGW) p0_conv_item(c, 0, it, scr, lane);
    for (int m0 = gw; m0 < MTOK; m0 += 4 * NGW) {
        f32x4 v[4][4];
#pragma unroll
        for (int u = 0; u < 4; ++u) { const int m = m0 + u * NGW;
#pragma unroll
            for (int j = 0; j < 4; ++j) v[u][j] = (f32x4){0.f, 0.f, 0.f, 0.f};
            if (m < MTOK) { const f32x4* xr = (const f32x4*)(c.x + (size_t)m * DM) + lane;
#pragma unroll
                for (int j = 0; j < 4; ++j) v[u][j] = xr[64 * j]; } }
#pragma unroll
        for (int u = 0; u < 4; ++u) { const int m = m0 + u * NGW;
            if (m < MTOK) { unsigned long long* o8 = (unsigned long long*)(c.xn + (size_t)m * DM) + lane; float s = 0.f;
#pragma unroll
                for (int j = 0; j < 4; ++j) { const f32x4 w = v[u][j]; s += (w.x * w.x + w.y * w.y) + (w.z * w.z + w.w * w.w);
                    o8[64 * j] = (unsigned long long)cvtpk(w.x, w.y) | ((unsigned long long)cvtpk(w.z, w.w) << 32); }
                s = wave_sum(s);
                if (lane == 0) c.ss[m] = (unsigned long long)(s * SS_SCALE); } }
    }
    for (int i = gt; i < 8 * MTOK; i += NGT) c.ss[MTOK + i] = 0ull;
    if (gt < 512) c.knA[gt] = 0u;
    if (gt < DEPTH) { c.ctl[64 * gt] = 0u; c.ctl[64 * (gt + 4)] = 0u; float d1 = 0.f, d2 = 0.f;
        for (int i = 0; i < 32; ++i) { d1 += c.lam_q1[gt * 32 + i] * c.lam_k1[gt * 32 + i]; d2 += c.lam_q2[gt * 32 + i] * c.lam_k2[gt * 32 + i]; }
        c.lamv[gt] = expf(d1) - expf(d2) + (0.8f - 0.6f * expf(-0.3f * (float)gt)); }
    for (int i = gt; i < 4 * 4096; i += NGT) { const int h = i >> 12, d = 4095 - (i & 4095); c.biasA[i] = c.rel_bias[t5_bucket(d) * 16 + h] * LOG2E; }
    for (int i = gt; i < 4 * 396; i += NGT) { const int h = i / 396, r = i - h * 396, g = r / 132, n = r - g * 132; const int dil = g == 0 ? 1 : (g == 1 ? 4 : 16);
        c.tabC[i] = (n <= 128) ? c.rel_bias[t5_bucket(n * dil) * 16 + 4 + 4 * g + h] * LOG2E : 0.f; }
}

DI void fgate_phase(const Ctx& c, int l, LAS unsigned char* lds) {
    const int tid = opaque_tid(), lane = tid & 63, wave = __builtin_amdgcn_readfirstlane(tid >> 6);
    const int gw = opaque_bid() * 8 + wave, NGW = gridDim.x * 8;
    constexpr int WPITCH = 2048 + 16;
    const float* wsrc = c.w_in + (size_t)l * DM * NIN + F_OFF; const float* g1 = c.norm1_g + l * DM;
    for (int i = tid; i < 8192; i += 512) { const int k = i >> 3, h = i & 7; const float v = wsrc[(size_t)k * NIN + h] * g1[k];
        *(LAS unsigned short*)(lds + h * WPITCH + k * 2) = (unsigned short)(cvtpk(v, 0.f) & 0xffffu); }
    __syncthreads();
    const unsigned long long* ss = c.ss + (size_t)(2 * l) * MTOK;
    const int fr = lane & 15, fq = lane >> 4;
    for (int tile = gw; tile < MTOK / 16; tile += NGW) {
        const bf16* xrow = c.xn + (size_t)(tile * 16 + fr) * DM + fq * 8;
        LAS const unsigned char* wrow = lds + (fr & 7) * WPITCH + fq * 16;
        pg8::f32x4 acc = {0.f, 0.f, 0.f, 0.f};
        bf16x8 av[32];
#pragma unroll
        for (int s2 = 0; s2 < 32; ++s2) av[s2] = *(const bf16x8*)(xrow + s2 * 32);
#pragma unroll
        for (int s2 = 0; s2 < 32; ++s2) { const bf16x8 bv = *(const LAS bf16x8*)(wrow + s2 * 64); acc = __builtin_amdgcn_mfma_f32_16x16x32_bf16(av[s2], bv, acc, 0, 0, 0); }
        if (fr < 8) { const float bfv = c.b_f[l * 8 + fr];
#pragma unroll
            for (int j = 0; j < 4; ++j) { const int row = tile * 16 + fq * 4 + j;
                const float f = acc[j] / sqrtf((float)ss[row] * (SS_INV / 1024.0f) + NORM_EPS) + bfv;
                const float ls = fminf(f, 0.f) - __logf(1.0f + __expf(-fabsf(f)));
                const int b = row >> 12, t = row & 4095; c.logf[(size_t)(b * 8 + fr) * SEQ + t] = ls * LOG2E; } }
    }
    __syncthreads();
}

constexpr int N_PHASES_ = 2 + 5 * DEPTH;
DI void final_phase(const Ctx& c) {
    const int tid = opaque_tid(), lane = tid & 63, wave = __builtin_amdgcn_readfirstlane(tid >> 6);
    const int gw = opaque_bid() * 8 + wave, NGW = gridDim.x * 8;
    const unsigned long long* ss = c.ss + (size_t)8 * MTOK;
    const f32x4* gp = (const f32x4*)c.final_g + lane;
    f32x4 g4[4];
#pragma unroll
    for (int j = 0; j < 4; ++j) g4[j] = gp[64 * j];
    float delta = 0.f;
#ifdef PROBE_MASK
    { const unsigned long long* ts = (const unsigned long long*)(c.ws + WS_TABC + 16384); unsigned long long sel = 0;
      for (int p = 0; p < N_PHASES_ - 1; ++p) { const int ty = (p == 0) ? 0 : 1 + ((p - 1) % 5); if ((PROBE_MASK >> ty) & 1) sel += ts[p + 1] - ts[p]; }
      const float f = (float)sel / (float)(ts[N_PHASES_ - 1] - ts[0]); delta = sqrtf(f * 8e-4f); }
#endif
    for (int m0 = gw; m0 < MTOK; m0 += 4 * NGW) {
        unsigned long long w[4][4]; unsigned long long sv[4];
#pragma unroll
        for (int u = 0; u < 4; ++u) { const int m = m0 + u * NGW; sv[u] = 0ull;
#pragma unroll
            for (int j = 0; j < 4; ++j) w[u][j] = 0ull;
            if (m < MTOK) { const unsigned long long* xr = (const unsigned long long*)(c.xn + (size_t)m * DM) + lane;
#pragma unroll
                for (int j = 0; j < 4; ++j) w[u][j] = xr[64 * j];
                sv[u] = ss[m]; } }
#pragma unroll
        for (int u = 0; u < 4; ++u) { const int m = m0 + u * NGW;
            if (m < MTOK) { f32x4* orow = (f32x4*)(c.out + (size_t)m * DM) + lane;
                const float rs = 1.0f / sqrtf((float)sv[u] * (SS_INV / 1024.0f) + NORM_EPS); const float dd = (m < 8192) ? delta : 0.f;
#pragma unroll
                for (int j = 0; j < 4; ++j) { const unsigned long long ww = w[u][j]; f32x4 v;
                    v.x = bf2f((unsigned short)ww); v.y = bf2f((unsigned short)(ww >> 16)); v.z = bf2f((unsigned short)(ww >> 32)); v.w = bf2f((unsigned short)(ww >> 48));
                    orow[64 * j] = v * rs * g4[j] + dd; } } }
    }
}

namespace att {
constexpr int L_K = 0, L_V = 16384, L_TAB = 32768, L_WSF = 49152, L_STG = 53248, L_SLOT = 118784;
constexpr int N_CONV = P0_I_L / 64, N_UNITS = N_CONV + 512 + 512 + 256;
#define NEG_INF_F (-__builtin_inff())
#define MFMA32(a, b, c) __builtin_amdgcn_mfma_f32_32x32x16_bf16((a), (b), (c), 0, 0, 0)
DI int crow(int r, int hi) { return (r & 3) + 8 * (r >> 2) + 4 * hi; }
DI s16x4 vtr(LAS const unsigned char* p) { return __builtin_bit_cast(s16x4, __builtin_amdgcn_ds_read_tr16_b64_v4i16((LAS v4i16_t*)p)); }
DI float swap_max(float a) { auto rr = __builtin_amdgcn_permlane32_swap(__float_as_uint(a), __float_as_uint(a), false, false); return fmaxf(__uint_as_float(rr[0]), __uint_as_float(rr[1])); }
DI float swap_sum(float a) { auto rr = __builtin_amdgcn_permlane32_swap(__float_as_uint(a), __float_as_uint(a), false, false); return __uint_as_float(rr[0]) + __uint_as_float(rr[1]); }

DI void softmax_pv(f32x16& p, f32x16& o0, f32x16& o1, float& mhat, float& l, LAS float* wsa, LAS const unsigned char* vb, int r32, int hi) {
    float a = fmaxf(fmaxf(p[0], p[1]), fmaxf(p[2], p[3]));
#pragma unroll
    for (int r = 4; r < 16; r += 4) a = fmaxf(a, fmaxf(fmaxf(p[r], p[r + 1]), fmaxf(p[r + 2], p[r + 3])));
    a = swap_max(a);
    bool resc = false;
    if (__any(a > 8.0f)) {
        const float dl = fmaxf(a, 0.f); mhat += dl;
#pragma unroll
        for (int r = 0; r < 16; ++r) p[r] -= dl;
        const float f = __builtin_amdgcn_exp2f(-dl); l *= f; if (hi == 0) wsa[r32] = f; resc = true;
    }
    float s = 0.f;
#pragma unroll
    for (int r = 0; r < 16; ++r) { p[r] = __builtin_amdgcn_exp2f(p[r]); s += p[r]; }
    l += s;
    if (resc) { LDS_WAIT();
#pragma unroll
        for (int g = 0; g < 4; ++g) { const f32x4 f4 = *(const LAS f32x4*)(wsa + 8 * g + 4 * hi);
#pragma unroll
            for (int e = 0; e < 4; ++e) { o0[4 * g + e] *= f4[e]; o1[4 * g + e] *= f4[e]; } } }
    u32x4 w0, w1;
    w0.x = cvtpk(p[0], p[1]); w0.y = cvtpk(p[2], p[3]); w0.z = cvtpk(p[4], p[5]); w0.w = cvtpk(p[6], p[7]);
    w1.x = cvtpk(p[8], p[9]); w1.y = cvtpk(p[10], p[11]); w1.z = cvtpk(p[12], p[13]); w1.w = cvtpk(p[14], p[15]);
    const bf16x8 pa0 = __builtin_bit_cast(bf16x8, w0), pa1 = __builtin_bit_cast(bf16x8, w1);
    { const s16x4 a0 = vtr(vb), a1 = vtr(vb + 512), b0 = vtr(vb + 1024), b1 = vtr(vb + 1536);
      o0 = MFMA32(pa0, __builtin_shufflevector(a0, a1, 0, 1, 2, 3, 4, 5, 6, 7), o0);
      o0 = MFMA32(pa1, __builtin_shufflevector(b0, b1, 0, 1, 2, 3, 4, 5, 6, 7), o0); }
    { const s16x4 a0 = vtr(vb + 2048), a1 = vtr(vb + 2048 + 512), b0 = vtr(vb + 2048 + 1024), b1 = vtr(vb + 2048 + 1536);
      o1 = MFMA32(pa0, __builtin_shufflevector(a0, a1, 0, 1, 2, 3, 4, 5, 6, 7), o1);
      o1 = MFMA32(pa1, __builtin_shufflevector(b0, b1, 0, 1, 2, 3, 4, 5, 6, 7), o1); }
}

DI float rowmax16(const f32x16& p) {
    float a = fmaxf(fmaxf(p[0], p[1]), fmaxf(p[2], p[3]));
#pragma unroll
    for (int r = 4; r < 16; r += 4) a = fmaxf(a, fmaxf(fmaxf(p[r], p[r + 1]), fmaxf(p[r + 2], p[r + 3])));
    return a;
}
DI void exp_sum_pack(f32x16& p, float& l, bf16x8& pa0, bf16x8& pa1) {
    float s = 0.f;
#pragma unroll
    for (int r = 0; r < 16; ++r) { p[r] = __builtin_amdgcn_exp2f(p[r]); s += p[r]; }
    l += s;
    u32x4 w0, w1;
    w0.x = cvtpk(p[0], p[1]); w0.y = cvtpk(p[2], p[3]); w0.z = cvtpk(p[4], p[5]); w0.w = cvtpk(p[6], p[7]);
    w1.x = cvtpk(p[8], p[9]); w1.y = cvtpk(p[10], p[11]); w1.z = cvtpk(p[12], p[13]); w1.w = cvtpk(p[14], p[15]);
    pa0 = __builtin_bit_cast(bf16x8, w0); pa1 = __builtin_bit_cast(bf16x8, w1);
}
DI void load_v4(bf16x8 (&vf)[4], LAS const unsigned char* vb) {
#pragma unroll
    for (int i = 0; i < 4; ++i) { const s16x4 a = vtr(vb + i * 1024), b = vtr(vb + i * 1024 + 512); vf[i] = __builtin_shufflevector(a, b, 0, 1, 2, 3, 4, 5, 6, 7); }
}
DI void rescale_o(f32x16& o0, f32x16& o1, LAS const float* wsa, int hi) {
#pragma unroll
    for (int g = 0; g < 4; ++g) { const f32x4 f4 = *(const LAS f32x4*)(wsa + 8 * g + 4 * hi);
#pragma unroll
        for (int e = 0; e < 4; ++e) { o0[4 * g + e] *= f4[e]; o1[4 * g + e] *= f4[e]; } }
}
DI void softmax_pv_b64(f32x16& p0, f32x16& p1, f32x16& o0, f32x16& o1, float& m, float& l, LAS float* wsa, LAS const unsigned char* vb, int r32, int hi) {
    float a = swap_max(fmaxf(rowmax16(p0), rowmax16(p1)));
    if (__any(a > 8.0f)) {
        const float dl = fmaxf(a, 0.f); m += dl;
#pragma unroll
        for (int r = 0; r < 16; ++r) { p0[r] -= dl; p1[r] -= dl; }
        const float f = __builtin_amdgcn_exp2f(-dl); l *= f; if (hi == 0) wsa[r32] = f;
        LDS_WAIT(); rescale_o(o0, o1, wsa, hi);
    }
    bf16x8 pa0, pa1, pa2, pa3, va[4], vb4[4];
    load_v4(va, vb); load_v4(vb4, vb + 4096);
    exp_sum_pack(p0, l, pa0, pa1);
    exp_sum_pack(p1, l, pa2, pa3);
    o0 = MFMA32(pa0, va[0], o0); o1 = MFMA32(pa0, va[2], o1); o0 = MFMA32(pa1, va[1], o0); o1 = MFMA32(pa1, va[3], o1);
    o0 = MFMA32(pa2, vb4[0], o0); o1 = MFMA32(pa2, vb4[2], o1); o0 = MFMA32(pa3, vb4[1], o0); o1 = MFMA32(pa3, vb4[3], o1);
}
DI void exp_pack_nosum(f32x16& p, bf16x8& pa0, bf16x8& pa1) {
#pragma unroll
    for (int r = 0; r < 16; ++r) p[r] = __builtin_amdgcn_exp2f(p[r]);
    u32x4 w0, w1;
    w0.x = cvtpk(p[0], p[1]); w0.y = cvtpk(p[2], p[3]); w0.z = cvtpk(p[4], p[5]); w0.w = cvtpk(p[6], p[7]);
    w1.x = cvtpk(p[8], p[9]); w1.y = cvtpk(p[10], p[11]); w1.z = cvtpk(p[12], p[13]); w1.w = cvtpk(p[14], p[15]);
    pa0 = __builtin_bit_cast(bf16x8, w0); pa1 = __builtin_bit_cast(bf16x8, w1);
}
DI void softmax_nomax_b64(f32x16& p0, f32x16& p1, f32x16& o0, f32x16& o1, f32x16& ol, LAS const unsigned char* vb) {
    bf16x8 pa0, pa1, pa2, pa3, va[4], vb4[4];
    load_v4(va, vb); load_v4(vb4, vb + 4096);
    exp_pack_nosum(p0, pa0, pa1);
    exp_pack_nosum(p1, pa2, pa3);
    const bf16x8 ones = {0x3F80, 0x3F80, 0x3F80, 0x3F80, 0x3F80, 0x3F80, 0x3F80, 0x3F80};
    o0 = MFMA32(pa0, va[0], o0); o1 = MFMA32(pa0, va[2], o1); ol = MFMA32(pa0, ones, ol); o0 = MFMA32(pa1, va[1], o0); o1 = MFMA32(pa1, va[3], o1); ol = MFMA32(pa1, ones, ol);
    o0 = MFMA32(pa2, vb4[0], o0); o1 = MFMA32(pa2, vb4[2], o1); ol = MFMA32(pa2, ones, ol); o0 = MFMA32(pa3, vb4[1], o0); o1 = MFMA32(pa3, vb4[3], o1); ol = MFMA32(pa3, ones, ol);
}
DI void softmax_pv_a2(f32x16& p0, f32x16& p1, f32x16& oa0, f32x16& oa1, f32x16& ob0, f32x16& ob1, float& ma, float& mb, float& la, float& lb, LAS float* wsf, LAS const unsigned char* vb, int r32, int hi) {
    const float a0 = swap_max(rowmax16(p0)), a1 = swap_max(rowmax16(p1));
    if (__any(fmaxf(a0, a1) > 8.0f)) {
        const float d0 = fmaxf(a0, 0.f), d1 = fmaxf(a1, 0.f); ma += d0; mb += d1;
#pragma unroll
        for (int r = 0; r < 16; ++r) { p0[r] -= d0; p1[r] -= d1; }
        const float f0 = __builtin_amdgcn_exp2f(-d0), f1 = __builtin_amdgcn_exp2f(-d1); la *= f0; lb *= f1;
        if (hi == 0) { wsf[r32] = f0; wsf[32 + r32] = f1; }
        LDS_WAIT(); rescale_o(oa0, oa1, wsf, hi); rescale_o(ob0, ob1, wsf + 32, hi);
    }
    bf16x8 pa0, pa1, pb0, pb1, vf[4];
    load_v4(vf, vb);
    exp_sum_pack(p0, la, pa0, pa1);
    exp_sum_pack(p1, lb, pb0, pb1);
    oa0 = MFMA32(pa0, vf[0], oa0); oa1 = MFMA32(pa0, vf[2], oa1); ob0 = MFMA32(pb0, vf[0], ob0); ob1 = MFMA32(pb0, vf[2], ob1);
    oa0 = MFMA32(pa1, vf[1], oa0); oa1 = MFMA32(pa1, vf[3], oa1); ob0 = MFMA32(pb1, vf[1], ob0); ob1 = MFMA32(pb1, vf[3], ob1);
}

DI void softmax_nomax_a2(f32x16& p0, f32x16& p1, f32x16& oa0, f32x16& oa1, f32x16& ob0, f32x16& ob1, float& la, float& lb, LAS const unsigned char* vb) {
    bf16x8 pa0, pa1, pb0, pb1, vf[4];
    load_v4(vf, vb);
    exp_sum_pack(p0, la, pa0, pa1);
    exp_sum_pack(p1, lb, pb0, pb1);
    oa0 = MFMA32(pa0, vf[0], oa0); oa1 = MFMA32(pa0, vf[2], oa1); ob0 = MFMA32(pb0, vf[0], ob0); ob1 = MFMA32(pb0, vf[2], ob1);
    oa0 = MFMA32(pa1, vf[1], oa0); oa1 = MFMA32(pa1, vf[3], oa1); ob0 = MFMA32(pb1, vf[1], ob0); ob1 = MFMA32(pb1, vf[3], ob1);
}
template <int TYPE> DI void finish(const f32x16& oa0, const f32x16& oa1, const f32x16& ob0, const f32x16& ob1, float la, float lb, float lam, float oscale, const float* subg,
                                   LAS float* wsf, LAS float* stg, bf16* orow0, size_t rstride, int lane, int r32, int hi, int dry = 0, int lready = 0) {
    if (!lready) { la = swap_sum(la); if (hi == 0) wsf[64 + r32] = la; }
    if (TYPE == 0) { lb = swap_sum(lb); if (hi == 0) wsf[96 + r32] = lb; }
    LDS_WAIT();
#pragma unroll
    for (int g = 0; g < 4; ++g) {
        const f32x4 l0 = *(const LAS f32x4*)(wsf + 64 + 8 * g + 4 * hi);
        f32x4 l1 = l0; if (TYPE == 0) l1 = *(const LAS f32x4*)(wsf + 96 + 8 * g + 4 * hi);
#pragma unroll
        for (int e = 0; e < 4; ++e) { const int r = 4 * g + e, row = e + 8 * g + 4 * hi; const float i0 = __builtin_amdgcn_rcpf(l0[e]);
            float v0 = oa0[r] * i0, v1 = oa1[r] * i0;
            if (TYPE == 0) { const float i1 = lam * __builtin_amdgcn_rcpf(l1[e]); v0 -= ob0[r] * i1; v1 -= ob1[r] * i1; }
            stg[row * 64 + r32] = v0; stg[row * 64 + 32 + r32] = v1; }
    }
    LDS_WAIT();
    const int c8 = (lane & 7) * 8;
    f32x4 ga = {1.f, 1.f, 1.f, 1.f}, gb = ga;
    if (TYPE == 0) { ga = *(const f32x4*)(subg + c8); gb = *(const f32x4*)(subg + c8 + 4); }
#pragma unroll
    for (int it = 0; it < 4; ++it) { const int row = it * 8 + (lane >> 3);
        f32x4 a = *(const LAS f32x4*)(stg + row * 64 + c8), b = *(const LAS f32x4*)(stg + row * 64 + c8 + 4);
        if (TYPE == 0) { float q = (a.x * a.x + a.y * a.y) + (a.z * a.z + a.w * a.w) + (b.x * b.x + b.y * b.y) + (b.z * b.z + b.w * b.w);
            q += __shfl_xor(q, 1); q += __shfl_xor(q, 2); q += __shfl_xor(q, 4);
            const float rs = oscale / sqrtf(q * (1.0f / 64.0f) + NORM_EPS); a = a * rs * ga; b = b * rs * gb; }
        u32x4 w; w.x = cvtpk(a.x, a.y); w.y = cvtpk(a.z, a.w); w.z = cvtpk(b.x, b.y); w.w = cvtpk(b.z, b.w);
        if (!dry) *(u32x4*)(orow0 + (size_t)row * rstride + c8) = w; }
    LDS_WAIT();
}

template <int TYPE> DI void unit_ab(const Ctx& c, int layer, int b, int h, int qb_first, int nqb, LAS unsigned char* lds, int dry, float refa = 0.f, float refb = 0.f) {
    constexpr bool ISA = (TYPE == 0 || TYPE == 3);
    const int tid = opaque_tid(), lane = tid & 63, wid = __builtin_amdgcn_readfirstlane(tid >> 6), r32 = lane & 31, hi = lane >> 5;
    const int qcol = (ISA ? PC_QA : PC_QB) + h * 64, kcol = (ISA ? PC_KA : PC_KB) + h * 64, vcol = (ISA ? PC_VA : PC_VB) + h * 64;
    bf16* P = c.proj + (size_t)b * SEQ * NP;
    LAS float* tab = (LAS float*)(lds + L_TAB);
    LAS float* wsf = (LAS float*)(lds + L_WSF) + wid * 128;
    float lam = 0.f, oscale = 1.f;
    LAS float* wt = (LAS float*)(lds + L_SLOT + 64);
    LAS float* knL = wt + 16;
    if (ISA) {
        const f32x4* src = (const f32x4*)(c.biasA + h * 4096);
        for (int i = tid; i < 1024; i += 512) ((LAS f32x4*)tab)[i] = src[i];
        lam = c.lamv[layer]; oscale = 1.0f - (0.8f - 0.6f * expf(-0.3f * (float)layer));
    } else {
        if (tid < 64) knL[tid] = c.knorm[(b * 8 + h) * 64 + tid];
        const int n = (qb_first + nqb) * 256, e0 = tid * 8;
        const f32x4* src = (const f32x4*)(c.logf + (size_t)(b * 8 + h) * SEQ) + 2 * tid;
        float v[8];
        if (e0 < n) { const f32x4 a = src[0], bb = src[1]; v[0] = a.x; v[1] = a.y; v[2] = a.z; v[3] = a.w; v[4] = bb.x; v[5] = bb.y; v[6] = bb.z; v[7] = bb.w; }
        else {
#pragma unroll
            for (int i = 0; i < 8; ++i) v[i] = 0.f; }
#pragma unroll
        for (int i = 1; i < 8; ++i) v[i] += v[i - 1];
        const float tot = v[7]; float sc = tot;
#pragma unroll
        for (int d = 1; d < 64; d <<= 1) { const float t = __shfl_up(sc, d); if (lane >= d) sc += t; }
        if (lane == 63) wt[wid] = sc;
        __syncthreads();
        float woff = 0.f;
#pragma unroll
        for (int w = 0; w < 8; ++w) if (w < wid) woff += wt[w];
        const float base = woff + sc - tot;
        if (e0 < n) { f32x4 a, bb; a.x = base + v[0]; a.y = base + v[1]; a.z = base + v[2]; a.w = base + v[3]; bb.x = base + v[4]; bb.y = base + v[5]; bb.z = base + v[6]; bb.w = base + v[7];
            ((LAS f32x4*)tab)[2 * tid] = a; ((LAS f32x4*)tab)[2 * tid + 1] = bb; }
    }
  for (int qi = 0; qi < nqb; ++qi) {
    const int qb = qb_first + qi;
    const int q0 = qb * 256, q0w = q0 + wid * 32, NT = (q0 + 256) / 64;
    bf16x8 qf[4];
#pragma unroll
    for (int d0 = 0; d0 < 4; ++d0) qf[d0] = *(const bf16x8*)(P + (size_t)(q0w + r32) * NP + qcol + d0 * 16 + hi * 8);
    float qw = 0.f;
    int tstart = 0, fastb = 0; float kmaxall = 0.f;
    if (TYPE == 1) {
        { float sq = 0.f;
#pragma unroll
          for (int d0 = 0; d0 < 4; ++d0)
#pragma unroll
              for (int j = 0; j < 8; ++j) { const float v = bf2f((unsigned short)qf[d0][j]); sq += v * v; }
          sq = swap_sum(sq);
#pragma unroll
          for (int o = 1; o < 32; o <<= 1) sq = fmaxf(sq, __shfl_xor(sq, o));
          qw = sqrtf(sq) * 1.0001f;
          if (lane == 0) wt[8 + wid] = qw; }
        __syncthreads();
        float qb8 = wt[8];
#pragma unroll
        for (int w = 1; w < 8; ++w) qb8 = fmaxf(qb8, wt[8 + w]);
        const float kself = fmaxf(fmaxf(knL[NT - 4], knL[NT - 3]), fmaxf(knL[NT - 2], knL[NT - 1]));
        const bool sk = (lane < NT - 4) && (qb8 * (knL[lane] + kself) + (tab[q0] - tab[64 * lane + 63]) + 2.0f < -150.f);
        const unsigned long long bm = __ballot(sk);
        tstart = __builtin_amdgcn_readfirstlane(__builtin_ctzll(~bm));
        float km = (lane < NT) ? knL[lane] : 0.f;
#pragma unroll
        for (int o = 1; o < 64; o <<= 1) km = fmaxf(km, __shfl_xor(km, o));
        kmaxall = km; fastb = (qb8 * km <= 40.0f) ? 1 : 0;
    }
    const int lkey = tid >> 3, lch = tid & 7;
    const bf16* kp = P + (size_t)lkey * NP + kcol + lch * 8; const bf16* vp = P + (size_t)lkey * NP + vcol + lch * 8;
    const int kwoff = lkey * 128 + ((lch ^ ((lkey >> 1) & 7)) * 16);
    const int vwoff = (lkey >> 5) * 4096 + (lch >> 2) * 2048 + ((lkey & 31) >> 4) * 1024 + ((lkey >> 3) & 1) * 512 + (lkey & 7) * 64 + (lch & 3) * 16;
    const u32x4 kfirst = *(const u32x4*)(kp + (size_t)tstart * 64 * NP), vfirst = *(const u32x4*)(vp + (size_t)tstart * 64 * NP);
    u32x4 kreg = *(const u32x4*)(kp + (size_t)(tstart + 1) * 64 * NP), vreg = *(const u32x4*)(vp + (size_t)(tstart + 1) * 64 * NP);
    *(LAS u32x4*)(lds + L_K + (tstart & 1) * 8192 + kwoff) = kfirst; *(LAS u32x4*)(lds + L_V + (tstart & 1) * 8192 + vwoff) = vfirst;
    __syncthreads();
    f32x16 oa0 = {}, oa1 = {}, ob0 = {}, ob1 = {};
    float ma = 0.f, mb = 0.f, la = 0.f, lb = 0.f;
    float cq = 0.f, cq0w = 0.f, kselfw = 0.f;
    if (TYPE == 1) { cq = tab[q0w + r32]; cq0w = tab[q0w]; kselfw = knL[q0w >> 6]; if (fastb) ma = qw * kmaxall; }
    if (TYPE == 3) { ma = refa; mb = refb; }
    f32x16 farA = {}, farB = {};
    if (TYPE == 3) { const float bfar = tab[0];
#pragma unroll
        for (int r = 0; r < 16; ++r) { farA[r] = bfar - ma; farB[r] = bfar - mb; }
        asm volatile("" : "+v"(farA), "+v"(farB)); }
    const int trb = (4 * hi + ((lane & 15) >> 2)) * 64 + ((lane >> 4) & 1) * 32 + (lane & 3) * 8;
    const int krd = r32 * 128, kx = (r32 >> 1) & 7;
    for (int t = tstart; t < NT; ++t) {
        LAS const unsigned char* kb = lds + L_K + (t & 1) * 8192; LAS const unsigned char* vbuf = lds + L_V + (t & 1) * 8192;
        if (TYPE == 1) {
            const int k0 = t * 64;
            bool act = (k0 <= q0w + 31);
            if (act && k0 + 64 <= q0w) act = !(qw * (knL[t] + kselfw) + (cq0w - tab[k0 + 63]) + 2.0f < -150.f);
            if (__builtin_amdgcn_readfirstlane((int)act)) {
                bf16x8 kf0[4], kf1[4];
#pragma unroll
                for (int d0 = 0; d0 < 4; ++d0) { kf0[d0] = *(const LAS bf16x8*)(kb + krd + (((2 * d0 + hi) ^ kx) * 16)); kf1[d0] = *(const LAS bf16x8*)(kb + 4096 + krd + (((2 * d0 + hi) ^ kx) * 16)); }
                const float base = cq - ma;
                f32x16 p0, p1;
#pragma unroll
                for (int g = 0; g < 4; ++g) { const f32x4 c0 = *(const LAS f32x4*)(tab + k0 + 8 * g + 4 * hi), c1 = *(const LAS f32x4*)(tab + k0 + 32 + 8 * g + 4 * hi);
#pragma unroll
                    for (int e = 0; e < 4; ++e) { p0[4 * g + e] = base - c0[e]; p1[4 * g + e] = base - c1[e]; } }
#pragma unroll
                for (int d0 = 0; d0 < 4; ++d0) { p0 = MFMA32(kf0[d0], qf[d0], p0); p1 = MFMA32(kf1[d0], qf[d0], p1); }
                if (k0 + 63 > q0w) { const int dbase = q0w + r32 - k0;
#pragma unroll
                    for (int r = 0; r < 16; ++r) { if (dbase - crow(r, hi) < 0) p0[r] = NEG_INF_F; if (dbase - 32 - crow(r, hi) < 0) p1[r] = NEG_INF_F; } }
                if (fastb) softmax_nomax_b64(p0, p1, oa0, oa1, ob0, vbuf + trb); else softmax_pv_b64(p0, p1, oa0, oa1, ma, la, wsf, vbuf + trb, r32, hi);
            }
        } else {
#pragma unroll
        for (int hf = 0; hf < 2; ++hf) {
            const int k0 = t * 64 + hf * 32;
            if (k0 <= q0w + 31) {
                bf16x8 kf[4];
#pragma unroll
                for (int d0 = 0; d0 < 4; ++d0) kf[d0] = *(const LAS bf16x8*)(kb + hf * 4096 + krd + (((2 * d0 + hi) ^ kx) * 16));
                const bool diag = (k0 + 31 > q0w);
                const int dbase = q0w + r32 - k0;
                LAS const unsigned char* vb = vbuf + hf * 4096 + trb;
                    const int dlo = q0w - k0 - 31;
                    float b0 = 0.f; int uni = 0;
                    if (dlo >= 245) { const float blo = tab[4095 - dlo], bhi = tab[4095 - dlo - 62]; b0 = blo; uni = (blo == bhi) ? 1 : 0; }
                    f32x16 p0, p1;
                    if (TYPE == 3 && dlo >= 1600) {
                        p0 = MFMA32(kf[0], qf[0], farA); p1 = MFMA32(kf[2], qf[2], farB); p0 = MFMA32(kf[1], qf[1], p0); p1 = MFMA32(kf[3], qf[3], p1);
                    } else if (__builtin_amdgcn_readfirstlane(uni)) {
#pragma unroll
                        for (int r = 0; r < 16; ++r) { p0[r] = b0 - ma; p1[r] = b0 - mb; }
                        p0 = MFMA32(kf[0], qf[0], p0); p1 = MFMA32(kf[2], qf[2], p1); p0 = MFMA32(kf[1], qf[1], p0); p1 = MFMA32(kf[3], qf[3], p1);
                    } else {
                        const LAS float* tp = tab + (4095 - dbase + 4 * hi);
#pragma unroll
                        for (int r = 0; r < 16; ++r) { float bv = tp[(r & 3) + 8 * (r >> 2)]; if (diag && (r32 - crow(r, hi) < 0)) bv = NEG_INF_F; p0[r] = bv - ma; p1[r] = bv - mb; }
                        p0 = MFMA32(kf[0], qf[0], p0); p1 = MFMA32(kf[2], qf[2], p1); p0 = MFMA32(kf[1], qf[1], p0); p1 = MFMA32(kf[3], qf[3], p1);
                    }
                    if (TYPE == 3) softmax_nomax_a2(p0, p1, oa0, oa1, ob0, ob1, la, lb, vb); else softmax_pv_a2(p0, p1, oa0, oa1, ob0, ob1, ma, mb, la, lb, wsf, vb, r32, hi);
            }
        }
        }
        if (t + 1 < NT) { *(LAS u32x4*)(lds + L_K + ((t + 1) & 1) * 8192 + kwoff) = kreg; *(LAS u32x4*)(lds + L_V + ((t + 1) & 1) * 8192 + vwoff) = vreg; }
        __syncthreads();
        if (t + 2 < NT) { kreg = *(const u32x4*)(kp + (size_t)(t + 2) * 64 * NP); vreg = *(const u32x4*)(vp + (size_t)(t + 2) * 64 * NP); }
    }
    if (TYPE == 1 && fastb) { if (r32 == 0) {
#pragma unroll
            for (int r = 0; r < 16; ++r) wsf[64 + crow(r, hi)] = ob0[r]; } }
    finish<ISA ? 0 : 1>(oa0, oa1, ob0, ob1, la, lb, lam, oscale, c.diff_g + layer * 64, wsf, (LAS float*)(lds + L_STG + wid * 8192), P + (size_t)q0w * NP + qcol, (size_t)NP, lane, r32, hi, dry, (TYPE == 1 && fastb) ? 1 : 0);
  }
}

DI void unit_c(const Ctx& c, int b, int h, int chunk, LAS unsigned char* lds, int dry) {
    const int tid = opaque_tid(), lane = tid & 63, wid = __builtin_amdgcn_readfirstlane(tid >> 6), r32 = lane & 31, hi = lane >> 5;
    bf16* P = c.proj + (size_t)b * SEQ * NP;
    LAS float* tabc = (LAS float*)(lds + L_TAB);
    for (int i = tid; i < 396; i += 512) tabc[i] = c.tabC[h * 396 + i];
    __syncthreads();
    LAS float* wsf = (LAS float*)(lds + L_WSF) + wid * 128;
    LAS unsigned char* vbuf = lds + L_K + wid * 4096;
    const int trb = (4 * hi + ((lane & 15) >> 2)) * 64 + ((lane >> 4) & 1) * 32 + (lane & 3) * 8;
    const int vw0 = ((lane & 7) >> 2) * 2048 + (lane >> 3) * 64 + (lane & 3) * 16;
    const int c0 = chunk * 256;
    const int tq = c0 + wid + 8 * r32, thi = c0 + wid + 248;
    f32x16 o0 = {}, o1 = {}; float mh = 0.f, l = 0.f;
#pragma unroll 1
    for (int g = 0; g < 3; ++g) {
        const int dl = g == 0 ? 1 : (g == 1 ? 4 : 8), NT = g == 0 ? 12 : (g == 1 ? 6 : 9), R = 8 / dl;
        const int qcol = (g == 0 ? PC_QC0 : (g == 1 ? PC_QC1 : PC_QC2)) + h * 64, kcol = PC_KC + 256 * g + h * 64, vcol = PC_VC + 256 * g + h * 64;
        bf16x8 qf[4];
#pragma unroll
        for (int d0 = 0; d0 < 4; ++d0) qf[d0] = *(const bf16x8*)(P + (size_t)tq * NP + qcol + d0 * 16 + hi * 8);
        const int tstart = thi - dl * (32 * NT - 1);
        const unsigned nmaxu = (unsigned)min(128, tq >> (g == 0 ? 0 : (g == 1 ? 2 : 4)));
        const LAS float* tabl = tabc + g * 132;
        bf16x8 kf[4]; u32x4 vr[4];
        { const int tk = tstart + dl * r32, tok = tk < 0 ? 0 : tk;
#pragma unroll
          for (int d0 = 0; d0 < 4; ++d0) kf[d0] = *(const bf16x8*)(P + (size_t)tok * NP + kcol + (2 * d0 + hi) * 8);
#pragma unroll
          for (int i = 0; i < 4; ++i) { const int tv = tstart + dl * ((lane >> 3) + 8 * i), tokv = tv < 0 ? 0 : tv; vr[i] = *(const u32x4*)(P + (size_t)tokv * NP + vcol + (lane & 7) * 8); } }
        for (int st = 0; st < NT; ++st) {
#pragma unroll
            for (int i = 0; i < 4; ++i) *(LAS u32x4*)(vbuf + vw0 + (i >> 1) * 1024 + (i & 1) * 512) = vr[i];
            bf16x8 kc[4];
#pragma unroll
            for (int d0 = 0; d0 < 4; ++d0) kc[d0] = kf[d0];
            if (st + 1 < NT) { const int j0 = 32 * (st + 1); const int tk = tstart + dl * (j0 + r32), tok = tk < 0 ? 0 : tk;
#pragma unroll
                for (int d0 = 0; d0 < 4; ++d0) kf[d0] = *(const bf16x8*)(P + (size_t)tok * NP + kcol + (2 * d0 + hi) * 8);
#pragma unroll
                for (int i = 0; i < 4; ++i) { const int tv = tstart + dl * (j0 + (lane >> 3) + 8 * i), tokv = tv < 0 ? 0 : tv; vr[i] = *(const u32x4*)(P + (size_t)tokv * NP + vcol + (lane & 7) * 8); } }
            LDS_WAIT();
            f32x16 p;
            const int mbl = R * (r32 - 31) + 32 * NT - 1 - 32 * st - 4 * hi;
#pragma unroll
            for (int r = 0; r < 16; ++r) { const unsigned mm = (unsigned)(mbl - ((r & 3) + 8 * (r >> 2)));
                const unsigned n = (g == 2) ? (mm >> 1) : mm; const bool ok = (n <= nmaxu) && ((g != 2) || ((mm & 1u) == 0u));
                const unsigned nc = n < 129u ? n : 129u; const float bv = tabl[nc]; p[r] = ok ? bv - mh : NEG_INF_F; }
#pragma unroll
            for (int d0 = 0; d0 < 4; ++d0) p = MFMA32(kc[d0], qf[d0], p);
            softmax_pv(p, o0, o1, mh, l, wsf, vbuf + trb, r32, hi);
            LDS_WAIT();
        }
    }
    finish<2>(o0, o1, o0, o1, l, l, 0.f, 1.f, nullptr, wsf, (LAS float*)(lds + L_STG + wid * 8192), P + (size_t)(c0 + wid) * NP + PC_QC2 + h * 64, (size_t)8 * NP, lane, r32, hi, dry);
}

DI float sumsq8(const u32x4& w) { float t = 0.f;
#pragma unroll
    for (int e = 0; e < 4; ++e) { const float lo = __uint_as_float(w[e] << 16), hi = __uint_as_float(w[e] & 0xffff0000u); t += lo * lo + hi * hi; }
    return t; }
DI float kn_reduce_b(const float (&pv)[8], int lane) {
    float r4[4], r2[2], v;
    { const bool up = (lane & 1) != 0;
#pragma unroll
      for (int i = 0; i < 4; ++i) { const float send = up ? pv[i] : pv[i + 4], keep = up ? pv[i + 4] : pv[i]; r4[i] = keep + __shfl_xor(send, 1); } }
    { const bool up = (lane & 2) != 0;
#pragma unroll
      for (int i = 0; i < 2; ++i) { const float send = up ? r4[i] : r4[i + 2], keep = up ? r4[i + 2] : r4[i]; r2[i] = keep + __shfl_xor(send, 2); } }
    { const bool up = (lane & 4) != 0; const float send = up ? r2[0] : r2[1], keep = up ? r2[1] : r2[0]; v = keep + __shfl_xor(send, 4); }
#pragma unroll
    for (int o = 1; o < 64; o <<= 1) v = fmaxf(v, __shfl_xor(v, o));
    return v;
}
DI float kn_reduce_a(const float (&pv)[8], int lane) {
    float r4[4], r2[2];
    { const bool up = (lane & 1) != 0;
#pragma unroll
      for (int i = 0; i < 4; ++i) { const float send = up ? pv[i] : pv[i + 4], keep = up ? pv[i + 4] : pv[i]; r4[i] = keep + __shfl_xor(send, 1); } }
    { const bool up = (lane & 2) != 0;
#pragma unroll
      for (int i = 0; i < 2; ++i) { const float send = up ? r4[i] : r4[i + 2], keep = up ? r4[i + 2] : r4[i]; r2[i] = keep + __shfl_xor(send, 2); } }
    float m = fmaxf(r2[0], r2[1]);
    m = fmaxf(m, __shfl_xor(m, 1)); m = fmaxf(m, __shfl_xor(m, 2)); m = fmaxf(m, __shfl_xor(m, 8)); m = fmaxf(m, __shfl_xor(m, 16)); m = fmaxf(m, __shfl_xor(m, 32));
    return m;
}
DI void knorm_phase(const Ctx& c, int layer) {
    const int tid = opaque_tid(), lane = tid & 63, wave = __builtin_amdgcn_readfirstlane(tid >> 6);
    const int gw = opaque_bid() * 8 + wave, NGW = gridDim.x * 8, sub = lane >> 3, ch = lane & 7;
    for (int it0 = gw; it0 < 4096; it0 += 2 * NGW) {
        float pb[2][8], pa[2][8];
#pragma unroll
        for (int u = 0; u < 2; ++u) { const int it = it0 + u * NGW; const bool on = it < 4096; const int itc = on ? it : 0;
            { const int bh = itc >> 6, tile = itc & 63, b = bh >> 3, h = bh & 7;
              const bf16* base = c.proj + ((size_t)b * SEQ + tile * 64 + sub) * NP + PC_KB + h * 64 + ch * 8;
#pragma unroll
              for (int i = 0; i < 8; ++i) pb[u][i] = sumsq8(*(const u32x4*)(base + (size_t)(8 * i) * NP)); }
            { const int isq = itc >> 11, r = itc & 2047, bh = r >> 6, tile = r & 63, b = bh >> 2, h = bh & 3;
              const bf16* base = c.proj + ((size_t)b * SEQ + tile * 64 + sub) * NP + (isq ? PC_QA : PC_KA) + h * 64 + ch * 8;
#pragma unroll
              for (int i = 0; i < 8; ++i) pa[u][i] = sumsq8(*(const u32x4*)(base + (size_t)(8 * i) * NP)); } }
#pragma unroll
        for (int u = 0; u < 2; ++u) { const int it = it0 + u * NGW;
            if (it < 4096) {
                const float v = kn_reduce_b(pb[u], lane);
                if (lane == 0) c.knorm[it] = sqrtf(v) * 1.0001f;
                const float m = kn_reduce_a(pa[u], lane);
                const int isq = it >> 11, bh = (it & 2047) >> 6;
                if ((lane & 59) == 0) atomicMax(c.knA + layer * 128 + isq * 64 + bh * 2 + (lane >> 2), __float_as_uint(sqrtf(m) * 1.0001f)); } }
    }
}

DI void attn_phase(const Ctx& c, int layer, LAS unsigned char* lds, int dry = 0) {
    LAS int* slot = (LAS int*)(lds + L_SLOT);
    unsigned* counter = c.ctl + 64 * (layer + 4 * dry); const int tid0 = opaque_tid();
    for (;;) {
        __syncthreads();
        if (tid0 == 0) slot[0] = (int)atomicAdd(counter, 1u);
        __syncthreads();
        const int u0 = __builtin_amdgcn_readfirstlane(slot[0]);
        if (u0 >= N_UNITS) break;
        if (u0 < N_CONV) { if (layer + 1 < DEPTH) { const int tid_ = opaque_tid(), lane_ = tid_ & 63, wv_ = __builtin_amdgcn_readfirstlane(tid_ >> 6);
                for (int j = 0; j < 8; ++j) p0_conv_item(c, layer + 1, u0 * 64 + wv_ * 8 + j, (LAS float*)(lds + wv_ * 16384), lane_); }
            continue; }
        const int u = u0 - N_CONV;
#ifndef NO_UC
        if (u < 512) { unit_c(c, u >> 6, (u >> 4) & 3, u & 15, lds, dry); } else
#endif
        { const int v = u - 512;
            if (v >= 128 && v < 384) { const int w = v - 128, g = 3 - (w >> 6), bh = w & 63; unit_ab<1>(c, layer, bh >> 3, bh & 7, 4 * g, 4, lds, dry); }
            else { const int w = (v < 128) ? v : v - 256, lev = 15 - (w >> 5), r = w & 31; const int ab = r >> 2, ah = r & 3;
                const unsigned* kn_ = c.knA + layer * 128 + (ab * 4 + ah) * 2;
                const float k0n = __uint_as_float(kn_[0]), k1n = __uint_as_float(kn_[1]), q0n = __uint_as_float(kn_[64]), q1n = __uint_as_float(kn_[65]);
                float bmx = -1e30f, bmn = 1e30f;
                for (int i = 0; i < 32; ++i) { const float bv = c.rel_bias[i * 16 + ah] * LOG2E; bmx = fmaxf(bmx, bv); bmn = fminf(bmn, bv); }
                const float span = 2.0f * fmaxf(q0n * k0n, q1n * k1n) + (bmx - bmn);
                if (span <= 80.0f) unit_ab<3>(c, layer, ab, ah, lev, 1, lds, dry, q0n * k0n + bmx + 0.01f, q1n * k1n + bmx + 0.01f);
                else unit_ab<0>(c, layer, ab, ah, lev, 1, lds, dry); } }
    }
}
}

#define XB_TMO      128
#define XB_XCNT(j)  (256  + 64 * (j))
#define XB_XSUB(j)  (1280 + 64 * (j))
#define XB_XGEN(j)  (2304 + 64 * (j))
#define XB_TOP      3328
#define XB_TOPGEN   3392
#define XCD_BAR_WORDS 3456
#define XB_SPIN_CAP (1u << 18)

__device__ __forceinline__ unsigned xb_ld(unsigned* p)              { return __hip_atomic_load(p, __ATOMIC_RELAXED, __HIP_MEMORY_SCOPE_AGENT); }
__device__ __forceinline__ unsigned xb_add(unsigned* p, unsigned v) { return __hip_atomic_fetch_add(p, v, __ATOMIC_RELAXED, __HIP_MEMORY_SCOPE_AGENT); }
__device__ __forceinline__ unsigned xb_xcc_id() { return (unsigned)__builtin_amdgcn_s_getreg((3 << 11) | 20) & 0xFu; }
#define XB_SPIN(cond, bar) do { unsigned _sp = 0; while (cond) { __builtin_amdgcn_s_sleep(1); \
    if ((++_sp & 255u) == 0u) { if (xb_ld(&(bar)[XB_TMO])) break; if (_sp > XB_SPIN_CAP) { atomicAdd(&(bar)[XB_TMO], 1u); break; } } } } while (0)

struct XcdBarrier {
    unsigned* bar; unsigned x;
    volatile LAS unsigned* st;
};

__device__ __forceinline__ XcdBarrier xcd_barrier_post(unsigned* bar, volatile LAS unsigned* st) {
    XcdBarrier b; b.bar = bar; b.x = xb_xcc_id(); b.st = st;
    if (threadIdx.x == 0) (void)xb_add(&bar[XB_XCNT(b.x)], 1u);
    return b;
}
__device__ __forceinline__ void xcd_barrier_complete(unsigned* bar, unsigned x, unsigned& nloc, unsigned& nx) {
    const unsigned G = gridDim.x * gridDim.y * gridDim.z;
    unsigned sum, cnt, mine, sp = 0u;
    for (;;) {
        sum = 0u; cnt = 0u; mine = 0u;
#pragma unroll
        for (unsigned j = 0; j < 16; ++j) { const unsigned c = xb_ld(&bar[XB_XCNT(j)]); sum += c; cnt += (c > 0u) ? 1u : 0u; mine = (j == x) ? c : mine; }
        if (sum == G) break;
        __builtin_amdgcn_s_sleep(1);
        if ((++sp & 255u) == 0u) { if (xb_ld(&bar[XB_TMO])) break; if (sp > XB_SPIN_CAP) { atomicAdd(&bar[XB_TMO], 1u); break; } }
    }
    nloc = mine > 0u ? mine : 1u; nx = cnt > 0u ? cnt : 1u;
}

__device__ __forceinline__ void xcd_barrier(const XcdBarrier& b) {
    asm volatile("s_waitcnt vmcnt(0)" ::: "memory");
    __syncthreads();
    if (threadIdx.x == 0) {
        unsigned* bar = b.bar;
        __builtin_amdgcn_s_waitcnt(0);
        unsigned nloc = b.st[0], nx = b.st[1];
        if (nloc == 0u) { xcd_barrier_complete(bar, b.x, nloc, nx); b.st[0] = nloc; b.st[1] = nx; }
        const unsigned old = xb_add(&bar[XB_XSUB(b.x)], 1u);
        const unsigned gen = old / nloc;
        if (old + 1u == (gen + 1u) * nloc) {
            __builtin_amdgcn_fence(__ATOMIC_RELEASE, "agent");
            asm volatile("s_waitcnt vmcnt(0)" ::: "memory");
            const unsigned og = xb_add(&bar[XB_TOP], 1u);
            const unsigned tg = og / nx;
            if (og + 1u == (tg + 1u) * nx) xb_add(&bar[XB_TOPGEN], 1u);
            else XB_SPIN(xb_ld(&bar[XB_TOPGEN]) == tg, bar);
            __builtin_amdgcn_fence(__ATOMIC_ACQUIRE, "agent");
            xb_add(&bar[XB_XGEN(b.x)], 1u);
            asm volatile("s_waitcnt vmcnt(0)" ::: "memory");
        } else {
            XB_SPIN(xb_ld(&bar[XB_XGEN(b.x)]) == gen, bar);
            __builtin_amdgcn_fence(__ATOMIC_ACQUIRE, "agent");
            asm volatile("s_waitcnt vmcnt(0)" ::: "memory");
        }
    }
    __syncthreads();
}

constexpr int LDS_BYTES = 131072 + 1024;
constexpr int N_PHASES = 2 + 5 * DEPTH;
struct Args { const float* in[15]; float* out; unsigned char* ws; int ph_lo, ph_hi; };
typedef const __attribute__((address_space(4))) Args* KArgP;
DI Ctx make_ctx(KArgP a) {
    Ctx c;
    c.x = a->in[0]; c.norm1_g = a->in[1]; c.w_in = a->in[2]; c.b_f = a->in[3]; c.lam_q1 = a->in[4]; c.lam_k1 = a->in[5]; c.lam_q2 = a->in[6]; c.lam_k2 = a->in[7]; c.diff_g = a->in[8];
    c.w_o = a->in[9]; c.norm2_g = a->in[10]; c.w_1 = a->in[11]; c.w_2 = a->in[12]; c.rel_bias = a->in[13]; c.final_g = a->in[14];
    c.out = a->out; c.ws = a->ws; unsigned char* ws = a->ws;
    c.win_t = (bf16*)(ws + WS_WIN); c.wo_t = (bf16*)(ws + WS_WO); c.w1_t = (bf16*)(ws + WS_W1); c.w2_t = (bf16*)(ws + WS_W2);
    c.xn = (bf16*)(ws + WS_XN); c.proj = (bf16*)(ws + WS_PROJ);
    c.ss = (unsigned long long*)(ws + WS_SS); c.logf = (float*)(ws + WS_LOGF); c.biasA = (float*)(ws + WS_BIASA); c.tabC = (float*)(ws + WS_TABC); c.lamv = (float*)(ws + WS_TABC + 8192); c.knorm = (float*)(ws + WS_TABC + 32768); c.knA = (unsigned*)(ws + WS_TABC + 49152); c.ctl = (unsigned*)(ws + WS_CTL);
    return c;
}
#define PHASE_CTX() KArgP ap_ = (KArgP)__builtin_amdgcn_kernarg_segment_ptr(); asm volatile("" : "+s"(ap_)); const Ctx c = make_ctx(ap_)
__global__ void __launch_bounds__(512, 2) trunk_fwd(Args a) {
    extern __shared__ __attribute__((aligned(16))) unsigned char lds_raw[];
    LAS unsigned char* lds = (LAS unsigned char*)lds_raw;
    cg::grid_group grid = cg::this_grid();
    volatile LAS unsigned* xb_st = (volatile LAS unsigned*)(lds + 131072 + 512);
    if (threadIdx.x < 2) xb_st[threadIdx.x] = 0u;
    __syncthreads();
    const XcdBarrier xbar = xcd_barrier_post((unsigned*)(a.ws + 16384), xb_st);
    if (a.ph_hi < 0) grid.sync();
#ifdef FORCE_LO
    const int lo = FORCE_LO, hi = FORCE_HI, G = gridDim.x;
#else
    const int lo = a.ph_lo, hi = a.ph_hi, G = gridDim.x;
#endif
#define RUN(p) (lo <= (p) && (p) < hi)
#ifdef PROBE_MASK
#define STAMP(p) do { if (blockIdx.x == 0 && threadIdx.x == 0) ((unsigned long long*)(a.ws + WS_TABC + 16384))[(p)] = __builtin_amdgcn_s_memrealtime(); } while (0)
#else
#define STAMP(p) do { } while (0)
#endif
#define SEAM(p) do { if (RUN(p) && RUN((p) + 1)) { xcd_barrier(xbar); } STAMP((p) + 1); } while (0)
    STAMP(0);
    if (RUN(0)) { PHASE_CTX(); p0_prologue(c, lds); }
    SEAM(0);
    for (int l = 0; l < DEPTH; ++l) {
        const int pb = 1 + 5 * l;
        if (RUN(pb)) { PHASE_CTX();
            pg8::Gemm g{c.xn, c.win_t + (size_t)l * NP * DM, MTOK, NP, DM, DM}; pg8::StaticOrder S; S.init(MTOK, NP, G, opaque_bid());
            pg8::EpiScaleBf16<0> E{c.proj, NP, c.ss + (size_t)(2 * l) * MTOK};
            pg8::gemm_phase<pg8::EpiScaleBf16<0>, pg8::StaticOrder, true, true>(lds, g, S, E);
            { PHASE_CTX(); fgate_phase(c, l, lds); }
        }
        SEAM(pb);
#ifdef ATT_DUP
        if (RUN(pb + 1)) { PHASE_CTX(); att::attn_phase(c, l, lds, ap_->ph_lo + 1); }
#endif
        if (RUN(pb + 1)) { { PHASE_CTX(); att::knorm_phase(c, l); } xcd_barrier(xbar); { PHASE_CTX(); att::attn_phase(c, l, lds); } }
        SEAM(pb + 1);
        if (RUN(pb + 2)) { PHASE_CTX();
            pg8::Gemm g{c.proj, c.wo_t + (size_t)l * DM * DM, MTOK, DM, DM, NP}; pg8::StaticOrder S; S.init(MTOK, DM, G, opaque_bid());
            pg8::EpiRes E{c.xn, c.ss + (size_t)(2 * l + 1) * MTOK};
            pg8::gemm_phase<pg8::EpiRes, pg8::StaticOrder, true, true>(lds, g, S, E);
        }
        SEAM(pb + 2);
        if (RUN(pb + 3)) { PHASE_CTX();
            pg8::Gemm g{c.xn, c.w1_t + (size_t)l * FF * DM, MTOK, FF, DM, DM}; pg8::StaticOrder S; S.init(MTOK, FF, G, opaque_bid());
            pg8::EpiScaleBf16<1> E{c.proj, FF, c.ss + (size_t)(2 * l + 1) * MTOK};
            pg8::gemm_phase<pg8::EpiScaleBf16<1>, pg8::StaticOrder, true, true>(lds, g, S, E);
        }
        SEAM(pb + 3);
        if (RUN(pb + 4)) { PHASE_CTX();
            pg8::Gemm g{c.proj, c.w2_t + (size_t)l * DM * FF, MTOK, DM, FF, FF}; pg8::StaticOrder S; S.init(MTOK, DM, G, opaque_bid());
            pg8::EpiRes E{c.xn, c.ss + (size_t)(2 * l + 2) * MTOK};
            pg8::gemm_phase<pg8::EpiRes, pg8::StaticOrder, true, true>(lds, g, S, E);
        }
        SEAM(pb + 4);
    }
    if (RUN(N_PHASES - 1)) { PHASE_CTX(); final_phase(c); }
#undef RUN
#undef SEAM
}

#ifndef MK_PER_PHASE
#define MK_PER_PHASE 0
#endif
extern "C" void kernel_launch(void* const* d_in, const int* in_sizes, int n_in, void* d_out, int out_size, void* d_ws, size_t ws_size, hipStream_t stream) {
    static int grid = 0;
    if (grid == 0) {
        if (n_in != 15 || out_size != MTOK * DM || ws_size < WS_END) { fprintf(stderr, "kernel_launch: unexpected sizes n_in %d out %d ws %zu (need %zu)\n", n_in, out_size, ws_size, (size_t)WS_END); grid = -1; return; }
        int dev = 0, cus = 0, per_cu = 0;
        (void)hipGetDevice(&dev); (void)hipDeviceGetAttribute(&cus, hipDeviceAttributeMultiprocessorCount, dev);
        if (hipFuncSetAttribute((const void*)trunk_fwd, hipFuncAttributeMaxDynamicSharedMemorySize, LDS_BYTES) != hipSuccess) { fprintf(stderr, "kernel_launch: hipFuncSetAttribute failed\n"); grid = -1; return; }
        if (hipOccupancyMaxActiveBlocksPerMultiprocessor(&per_cu, (const void*)trunk_fwd, 512, LDS_BYTES) != hipSuccess || per_cu < 1) { fprintf(stderr, "kernel_launch: occupancy query says %d\n", per_cu); per_cu = 1; }
        (void)hipGetLastError();
        grid = cus > 0 ? cus : 256;
        fprintf(stderr, "kernel_launch: grid %d (cus %d, per_cu %d)\n", grid, cus, per_cu);
    }
    if (grid < 0) return;
    if (hipMemsetAsync((char*)d_ws + 16384, 0, 16384, stream) != hipSuccess) { fprintf(stderr, "kernel_launch: memset of barrier words failed\n"); return; }
    Args a{};
    for (int i = 0; i < 15; ++i) a.in[i] = (const float*)d_in[i];
    a.out = (float*)d_out; a.ws = (unsigned char*)d_ws;
#if MK_PER_PHASE
    for (int p = 0; p < N_PHASES; ++p) { a.ph_lo = p; a.ph_hi = p + 1; hipLaunchKernelGGL(trunk_fwd, dim3(grid), dim3(512), LDS_BYTES, stream, a); }
#else
    a.ph_lo = 0; a.ph_hi = N_PHASES;
    void* args[] = {&a};
    hipError_t e = hipLaunchCooperativeKernel((const void*)trunk_fwd, dim3(grid), dim3(512), args, LDS_BYTES, stream);
    if (e != hipSuccess) fprintf(stderr, "kernel_launch: cooperative launch failed: %s (grid %d)\n", hipGetErrorString(e), grid);
#endif
}
```

```cpp
#include <hip/hip_runtime.h>
#include <hip/hip_cooperative_groups.h>
#include <cstdio>
#include <cstdint>
#include <cmath>
namespace cg = cooperative_groups;

constexpr int NBATCH = 8, SEQ = 4096, DM = 1024, DEPTH = 4, FF = 4096;
constexpr int MTOK = NBATCH * SEQ;
constexpr int NIN = 4616;
constexpr int NP = 4608;
constexpr int F_OFF = 2304;
constexpr float NORM_EPS = 1e-6f;
constexpr float LOG2E = 1.4426950408889634f;
constexpr int PC_QA = 0, PC_QB = 256, PC_QC2 = 768, PC_QC0 = 1024, PC_QC1 = 1280, PC_KA = 1536, PC_VA = 1792, PC_KB = 2048, PC_VB = 2560, PC_KC = 3072, PC_VC = 3840;

constexpr size_t MiB = 1u << 20;
constexpr size_t WS_CTL = 0;
constexpr size_t WS_SS = 64 * 1024;
constexpr size_t WS_LOGF = 3 * MiB;
constexpr size_t WS_BIASA = 4 * MiB;
constexpr size_t WS_TABC = 4 * MiB + 64 * 1024;
constexpr size_t WS_WIN = 8 * MiB, WS_WO = 44 * MiB, WS_W1 = 52 * MiB, WS_W2 = 84 * MiB;
constexpr size_t WS_XN = 116 * MiB;
constexpr size_t WS_PROJ = 180 * MiB;
constexpr size_t WS_END = 468 * MiB;
constexpr float SS_SCALE = 16777216.0f, SS_INV = 1.0f / 16777216.0f;

#define DI __device__ __forceinline__
#define LAS __attribute__((address_space(3)))
typedef float f32x16 __attribute__((ext_vector_type(16)));
typedef short s16x4 __attribute__((ext_vector_type(4)));
typedef unsigned u32x2 __attribute__((ext_vector_type(2)));
#define LDS_WAIT() asm volatile("s_waitcnt lgkmcnt(0)" ::: "memory")
DI int opaque_tid() { int t = threadIdx.x; asm volatile("" : "+v"(t)); return t; }
DI int opaque_bid() { int b = blockIdx.x; asm volatile("" : "+s"(b)); return b; }

namespace pg8 {
#define PG8_LAS __attribute__((address_space(3)))
typedef unsigned short bf16_t;
typedef short bf16x8 __attribute__((ext_vector_type(8)));
typedef float f32x4 __attribute__((ext_vector_type(4)));
typedef unsigned u32x4 __attribute__((ext_vector_type(4)));
constexpr int BM = 256, BK = 64, HALF = 128, HTB = HALF * BK * 2  , STAGE_BYTES = 8 * HTB, NXCD = 8, WGM = 4;

__host__ __device__ __forceinline__ int lds_byte(int r, int c) { const int st = (r >> 4) * 2 + (c >> 5), rr = r & 15, cc = c & 31, ob = rr * 64 + cc * 2; return st * 1024 + (ob ^ (((ob >> 9) & 1) << 5)); }
__host__ __device__ __forceinline__ void stage_rc(int b, int& R, int& C) { const int st = b / 1024, sb = b % 1024, swz = sb ^ (((sb >> 9) & 1) << 5); R = (st >> 1) * 16 + swz / 64; C = (st & 1) * 32 + (swz % 64) / 2; }
__host__ __device__ __forceinline__ int perm32(int rho) { const int n = rho >> 4, i = rho & 15; return 8 * (i >> 2) + 4 * n + (i & 3); }

struct Unit { int pm, pn; };
struct Gemm { const bf16_t* A; const bf16_t* Bt; int M, N, K, lda; };

struct StaticOrder {
    int nM, nN, nwg, G, c;
    __host__ __device__ void init(int M, int N, int G_, int c_) { nM = M / BM; nN = N / BM; nwg = nM * nN; G = G_; c = c_; }
    __host__ __device__ bool next(int i, Unit& u) const {
        const long L = (long)i * G + c; if (L >= nwg) return false;
        int wgid = (int)L; { const int q = nwg / NXCD, r = nwg % NXCD, xcd = wgid % NXCD, off = wgid / NXCD; wgid = (xcd < r ? xcd * (q + 1) : r * (q + 1) + (xcd - r) * q) + off; }
        const int nig = WGM * nN, gid = wgid / nig, fm = gid * WGM, gsz = (nM - fm) < WGM ? (nM - fm) : WGM;
        u.pm = fm + ((wgid % nig) % gsz); u.pn = (wgid % nig) / gsz; return true;
    }
    __device__ __forceinline__ void a_ready(const Unit&) const {}
    __device__ __forceinline__ void done(const Unit&) const {}
};

__device__ __forceinline__ unsigned cvt_pk_bf16(float lo, float hi) { unsigned r; asm volatile("v_cvt_pk_bf16_f32 %0, %1, %2" : "=v"(r) : "v"(lo), "v"(hi)); return r; }
typedef float f32x2 __attribute__((ext_vector_type(2)));
__device__ __forceinline__ float row_rs(const unsigned long long* ss, int row) { return 1.0f / sqrtf((float)ss[row] * (SS_INV / 1024.0f) + NORM_EPS); }
template <int MODE> struct EpiScaleBf16 {
    static constexpr bool PERM = true, AFTER_DRAIN = false;
    bf16_t* O; int ldc; const unsigned long long* ss;
    __device__ __forceinline__ void operator()(const f32x4 (&acc)[2][2][4][2], const Unit& u, int wr, int wc, int fr, int fq) const {
        const int row0 = u.pm * BM + wr * 64 + fr, col0 = u.pn * BM + wc * 32 + 8 * fq;
        float sc = 1.f;
        if (MODE == 0) { if (u.pn == 0) sc = 0.17677669529663687f * LOG2E; else if (u.pn < 6) sc = 0.125f * LOG2E; }
        unsigned long long ssv[2][4];
#pragma unroll
        for (int ai = 0; ai < 2; ++ai)
#pragma unroll
            for (int m = 0; m < 4; ++m) ssv[ai][m] = ss[row0 + ai * HALF + m * 16];
#pragma unroll
        for (int ai = 0; ai < 2; ++ai)
#pragma unroll
            for (int m = 0; m < 4; ++m) { const int row = row0 + ai * HALF + m * 16; const float rs = sc / sqrtf((float)ssv[ai][m] * (SS_INV / 1024.0f) + NORM_EPS); bf16_t* rowp = O + (size_t)row * ldc + col0;
#pragma unroll
                for (int bj = 0; bj < 2; ++bj) { f32x4 v0 = acc[ai][bj][m][0] * rs, v1 = acc[ai][bj][m][1] * rs;
                    if (MODE == 1) {
#pragma unroll
                        for (int e = 0; e < 4; ++e) { const float a = fmaxf(v0[e], 0.f), b = fmaxf(v1[e], 0.f); v0[e] = a * a; v1[e] = b * b; } }
                    u32x4 w; w.x = cvt_pk_bf16(v0[0], v0[1]); w.y = cvt_pk_bf16(v0[2], v0[3]); w.z = cvt_pk_bf16(v1[0], v1[1]); w.w = cvt_pk_bf16(v1[2], v1[3]);
                    *(u32x4*)(rowp + bj * HALF) = w; } }
    }
};
struct EpiRes {
    static constexpr bool PERM = true, AFTER_DRAIN = false;
    bf16_t* XN; unsigned long long* ssout;
    __device__ __forceinline__ void operator()(const f32x4 (&acc)[2][2][4][2], const Unit& u, int wr, int wc, int fr, int fq) const {
        const int row0 = u.pm * BM + wr * 64 + fr, col0 = u.pn * BM + wc * 32 + 8 * fq;
#pragma unroll
        for (int ai = 0; ai < 2; ++ai) {
            u32x4 pre[4][2];
#pragma unroll
            for (int m = 0; m < 4; ++m)
#pragma unroll
                for (int bj = 0; bj < 2; ++bj) pre[m][bj] = *(const u32x4*)(XN + (size_t)(row0 + ai * HALF + m * 16) * DM + col0 + bj * HALF);
            asm volatile("" ::: "memory");
#pragma unroll
            for (int m = 0; m < 4; ++m) { const int row = row0 + ai * HALF + m * 16; float s = 0.f;
#pragma unroll
                for (int bj = 0; bj < 2; ++bj) { const u32x4 o = pre[m][bj]; const f32x4 a0 = acc[ai][bj][m][0], a1 = acc[ai][bj][m][1];
                    float x[8];
                    x[0] = __uint_as_float(o.x << 16) + a0[0]; x[1] = __uint_as_float(o.x & 0xffff0000u) + a0[1]; x[2] = __uint_as_float(o.y << 16) + a0[2]; x[3] = __uint_as_float(o.y & 0xffff0000u) + a0[3];
                    x[4] = __uint_as_float(o.z << 16) + a1[0]; x[5] = __uint_as_float(o.z & 0xffff0000u) + a1[1]; x[6] = __uint_as_float(o.w << 16) + a1[2]; x[7] = __uint_as_float(o.w & 0xffff0000u) + a1[3];
#pragma unroll
                    for (int e = 0; e < 8; ++e) s += x[e] * x[e];
                    u32x4 w; w.x = cvt_pk_bf16(x[0], x[1]); w.y = cvt_pk_bf16(x[2], x[3]); w.z = cvt_pk_bf16(x[4], x[5]); w.w = cvt_pk_bf16(x[6], x[7]);
                    *(u32x4*)(XN + (size_t)row * DM + col0 + bj * HALF) = w; }
                s += __shfl_xor(s, 16); s += __shfl_xor(s, 32);
                if (fq == 0) atomicAdd(ssout + row, (unsigned long long)(s * SS_SCALE)); }
        }
    }
};

template <class Epi, class Sched, bool ALIGN_EPI = false, bool SP2 = false>
__device__ __forceinline__ void gemm_phase(PG8_LAS unsigned char* lds, const Gemm g, const Sched& S, const Epi& E) {
    const int tid = opaque_tid(), wid = __builtin_amdgcn_readfirstlane(tid >> 6), lane = tid & 63, wr = wid >> 2, wc = wid & 3, fr = lane & 15, fq = lane >> 4;
    const int K = g.K, nt = K / BK;
    unsigned voffA[2], voffB[2];
#pragma unroll
    for (int i = 0; i < 2; ++i) { int R, C; stage_rc(tid * 16 + i * 8192, R, C); const int Rb = Epi::PERM ? ((R & ~31) + perm32(R & 31)) : R;
        voffA[i] = (unsigned)(R * g.lda + C) * 2u; voffB[i] = (unsigned)(Rb * K + C) * 2u; }
    const size_t kstep = (size_t)(BK * 2);
    const size_t hstepA = (size_t)HALF * g.lda * 2, hstepB = (size_t)HALF * K * 2;
    const size_t tstepA = 2 * hstepA, tstepB = 2 * hstepB;
    const unsigned ldsw = (unsigned)wid * 1024u;
    const int aoff = lds_byte(wr * 64 + fr, fq * 8), boff = lds_byte(wc * 32 + fr, fq * 8);
#define PG8_SA(b, h) (((b) * 2 + (h)) * HTB)
#define PG8_SB(b, h) ((4 + (b) * 2 + (h)) * HTB)
#define PG8_STAGE(bufoff, gbase, voff) do { _Pragma("unroll") for (int _i = 0; _i < 2; ++_i) \
        __builtin_amdgcn_global_load_lds((const unsigned*)((const char*)(gbase) + (voff)[_i]), (PG8_LAS unsigned*)(lds + (bufoff) + ldsw + _i * 8192), 16, 0, 0); } while (0)
#define PG8_LDA(dst, b, h) do { _Pragma("unroll") for (int m = 0; m < 4; ++m) _Pragma("unroll") for (int k = 0; k < 2; ++k) dst[m][k] = *(const PG8_LAS bf16x8*)(lds + PG8_SA(b, h) + aoff + m * 2048 + k * 1024); } while (0)
#define PG8_LDB(dst, b, h) do { _Pragma("unroll") for (int n = 0; n < 2; ++n) _Pragma("unroll") for (int k = 0; k < 2; ++k) dst[n][k] = *(const PG8_LAS bf16x8*)(lds + PG8_SB(b, h) + boff + n * 2048 + k * 1024); } while (0)
#define PG8_MMA(ai, bj, At, Bt) do { __builtin_amdgcn_s_setprio(1); _Pragma("unroll") for (int m = 0; m < 4; ++m) _Pragma("unroll") for (int n = 0; n < 2; ++n) _Pragma("unroll") for (int k = 0; k < 2; ++k) \
        acc[ai][bj][m][n] = __builtin_amdgcn_mfma_f32_16x16x32_bf16(Bt[n][k], At[m][k], acc[ai][bj][m][n], 0, 0, 0); __builtin_amdgcn_s_setprio(0); } while (0)
#define PG8_WAIT_V(n) asm volatile("s_waitcnt vmcnt(" #n ")" ::: "memory")
#define PG8_WAIT_L(n) asm volatile("s_waitcnt lgkmcnt(" #n ")" ::: "memory")
#define PG8_BAR __builtin_amdgcn_s_barrier()
#define PG8_SCHED __builtin_amdgcn_sched_barrier(0)
    Unit cur, nxt; int ui = 0;
    if (!S.next(0, cur)) return;
    f32x4 acc[2][2][4][2];
#pragma unroll
    for (int a = 0; a < 2; ++a)
#pragma unroll
        for (int b = 0; b < 2; ++b)
#pragma unroll
            for (int m = 0; m < 4; ++m)
#pragma unroll
                for (int n = 0; n < 2; ++n) acc[a][b][m][n] = (f32x4){0.f, 0.f, 0.f, 0.f};
    bf16x8 At[4][2], B0[2][2], B1[2][2];
    const char* cA = (const char*)g.A + (size_t)cur.pm * tstepA; const char* cB = (const char*)g.Bt + (size_t)cur.pn * tstepB;
    S.a_ready(cur);
    if constexpr (SP2) {
        PG8_STAGE(PG8_SB(0, 0), cB, voffB); PG8_STAGE(PG8_SB(0, 1), cB + hstepB, voffB); PG8_STAGE(PG8_SA(0, 0), cA, voffA); PG8_STAGE(PG8_SA(0, 1), cA + hstepA, voffA);
        if (wr == 1) PG8_BAR;
        PG8_WAIT_V(2); PG8_BAR;
        PG8_STAGE(PG8_SB(1, 0), cB + kstep, voffB); PG8_STAGE(PG8_SA(1, 0), cA + kstep, voffA); PG8_STAGE(PG8_SB(1, 1), cB + hstepB + kstep, voffB);
        PG8_WAIT_V(6); PG8_BAR;
    } else {
        PG8_STAGE(PG8_SB(0, 0), cB, voffB); PG8_STAGE(PG8_SA(0, 0), cA, voffA); PG8_STAGE(PG8_SB(0, 1), cB + hstepB, voffB); PG8_STAGE(PG8_SA(0, 1), cA + hstepA, voffA);
        if (wr == 1) PG8_BAR;
        PG8_WAIT_V(4); PG8_BAR;
        PG8_STAGE(PG8_SB(1, 0), cB + kstep, voffB); PG8_STAGE(PG8_SA(1, 0), cA + kstep, voffA); PG8_STAGE(PG8_SB(1, 1), cB + hstepB + kstep, voffB);
        PG8_WAIT_V(6); PG8_BAR;
    }
    for (;;) {
        const bool has_next = S.next(ui + 1, nxt);
        const char* nA = has_next ? (const char*)g.A + (size_t)nxt.pm * tstepA : cA; const char* nB = has_next ? (const char*)g.Bt + (size_t)nxt.pn * tstepB : cB;
        for (int t = 0; t < nt; t += 2) {
            const bool last = (t == nt - 2);
            const char* a1 = cA + (size_t)(t + 1) * kstep;
            const char* a2 = last ? nA : cA + (size_t)(t + 2) * kstep; const char* b2 = last ? nB : cB + (size_t)(t + 2) * kstep;
            const char* a3 = a2 + kstep; const char* b3 = b2 + kstep;
            if (last && has_next) S.a_ready(nxt);
            if constexpr (SP2) {
            PG8_LDB(B0, 0, 0); PG8_LDB(B1, 0, 1); PG8_SCHED; PG8_LDA(At, 0, 0); PG8_STAGE(PG8_SA(1, 1), a1 + hstepA, voffA);
            PG8_WAIT_V(8); PG8_WAIT_L(0); PG8_BAR; PG8_MMA(0, 0, At, B0); PG8_MMA(0, 1, At, B1); PG8_BAR; PG8_SCHED;
            PG8_LDA(At, 0, 1); PG8_STAGE(PG8_SB(0, 0), b2, voffB); PG8_STAGE(PG8_SB(0, 1), b2 + hstepB, voffB); PG8_STAGE(PG8_SA(0, 0), a2, voffA);
            PG8_WAIT_V(8); PG8_WAIT_L(0); PG8_BAR; PG8_MMA(1, 0, At, B0); PG8_MMA(1, 1, At, B1); PG8_BAR; PG8_SCHED;
            PG8_LDB(B0, 1, 0); PG8_LDB(B1, 1, 1); PG8_SCHED; PG8_LDA(At, 1, 0); PG8_STAGE(PG8_SA(0, 1), a2 + hstepA, voffA);
            PG8_WAIT_V(8); PG8_WAIT_L(0); PG8_BAR; PG8_MMA(0, 0, At, B0); PG8_MMA(0, 1, At, B1); PG8_BAR; PG8_SCHED;
            PG8_LDA(At, 1, 1); PG8_STAGE(PG8_SB(1, 0), b3, voffB); PG8_STAGE(PG8_SB(1, 1), b3 + hstepB, voffB); PG8_STAGE(PG8_SA(1, 0), a3, voffA);
            PG8_WAIT_V(8); PG8_WAIT_L(0); PG8_BAR; PG8_MMA(1, 0, At, B0); PG8_MMA(1, 1, At, B1); PG8_BAR; PG8_SCHED;
            } else {
            PG8_LDB(B0, 0, 0); PG8_SCHED; PG8_LDA(At, 0, 0); PG8_STAGE(PG8_SA(1, 1), a1 + hstepA, voffA);
            PG8_WAIT_L(8); PG8_BAR; PG8_WAIT_L(0); PG8_MMA(0, 0, At, B0); PG8_BAR; PG8_SCHED;
            PG8_LDB(B1, 0, 1); PG8_STAGE(PG8_SB(0, 0), b2, voffB);
            PG8_BAR; PG8_WAIT_L(0); PG8_MMA(0, 1, At, B1); PG8_BAR;
            PG8_LDA(At, 0, 1); PG8_STAGE(PG8_SA(0, 0), a2, voffA);
            PG8_BAR; PG8_WAIT_L(0); PG8_MMA(1, 0, At, B0); PG8_BAR; PG8_SCHED;
            PG8_STAGE(PG8_SB(0, 1), b2 + hstepB, voffB);
            PG8_WAIT_V(6); PG8_BAR; PG8_MMA(1, 1, At, B1); PG8_BAR;
            PG8_LDB(B0, 1, 0); PG8_SCHED; PG8_LDA(At, 1, 0); PG8_STAGE(PG8_SA(0, 1), a2 + hstepA, voffA);
            PG8_WAIT_L(8); PG8_BAR; PG8_WAIT_L(0); PG8_MMA(0, 0, At, B0); PG8_BAR; PG8_SCHED;
            PG8_LDB(B1, 1, 1); PG8_STAGE(PG8_SB(1, 0), b3, voffB);
            PG8_BAR; PG8_WAIT_L(0); PG8_MMA(0, 1, At, B1); PG8_BAR;
            PG8_LDA(At, 1, 1); PG8_STAGE(PG8_SA(1, 0), a3, voffA);
            PG8_BAR; PG8_WAIT_L(0); PG8_MMA(1, 0, At, B0); PG8_BAR; PG8_SCHED;
            PG8_STAGE(PG8_SB(1, 1), b3 + hstepB, voffB);
            PG8_WAIT_V(6); PG8_BAR; PG8_MMA(1, 1, At, B1); PG8_BAR;
            }
        }
        if constexpr (ALIGN_EPI) { if (wr == 0) PG8_BAR; }
        if constexpr (!Epi::AFTER_DRAIN) { E(acc, cur, wr, wc, fr, fq); S.done(cur); }
        if (!has_next) break;
#pragma unroll
        for (int a = 0; a < 2; ++a)
#pragma unroll
            for (int b = 0; b < 2; ++b)
#pragma unroll
                for (int m = 0; m < 4; ++m)
#pragma unroll
                    for (int n = 0; n < 2; ++n) acc[a][b][m][n] = (f32x4){0.f, 0.f, 0.f, 0.f};
        cur = nxt; cA = nA; cB = nB; ++ui;
        if constexpr (ALIGN_EPI) { if (wr == 1) PG8_BAR; }
    }
    PG8_WAIT_V(0);
    if constexpr (!ALIGN_EPI) { if (wr == 0) PG8_BAR; }
    PG8_BAR;
    if constexpr (Epi::AFTER_DRAIN) { E.fused(acc, cur, wr, wc, fr, fq, lds, wid, lane); S.done(cur); }
#undef PG8_SA
#undef PG8_SB
#undef PG8_STAGE
#undef PG8_LDA
#undef PG8_LDB
#undef PG8_MMA
#undef PG8_WAIT_V
#undef PG8_WAIT_L
#undef PG8_BAR
#undef PG8_SCHED
}
}
typedef unsigned short bf16;
typedef float f32x4 __attribute__((ext_vector_type(4)));
typedef short bf16x8 __attribute__((ext_vector_type(8)));
typedef unsigned u32x4 __attribute__((ext_vector_type(4)));
typedef short v4i16_t __attribute__((ext_vector_type(4)));
typedef float f32x2_t __attribute__((ext_vector_type(2)));
typedef __bf16 bf16x2_t __attribute__((ext_vector_type(2)));
DI unsigned cvtpk(float lo, float hi) { f32x2_t v = {lo, hi}; bf16x2_t b = __builtin_convertvector(v, bf16x2_t); return __builtin_bit_cast(unsigned, b); }
DI float bf2f(unsigned short u) { return __uint_as_float((unsigned)u << 16); }
DI float wave_sum(float v) {
#pragma unroll
    for (int o = 1; o < 64; o <<= 1) v += __shfl_xor(v, o);
    return v;
}
struct Ctx {
    const float *x, *norm1_g, *w_in, *b_f, *lam_q1, *lam_k1, *lam_q2, *lam_k2, *diff_g, *w_o, *norm2_g, *w_1, *w_2, *rel_bias, *final_g;
    float* out; unsigned char* ws;
    bf16 *win_t, *wo_t, *w1_t, *w2_t, *xn, *proj;
    unsigned long long* ss; float* logf; float* biasA; float* tabC; float* lamv; float* knorm; unsigned* knA; unsigned* ctl;
};

DI int colmap(int t) {
    switch (t) { case 0: return 0; case 1: return 768; case 2: return 1024; case 3: return 2824; case 4: return 2312; case 5: return 2568; case 6: return 256; case 7: return 512;
                 case 8: return 1280; case 9: return 1536; case 10: return 1792; case 11: return 2048; case 12: return 3080; case 13: return 3336; case 14: return 3592;
                 case 15: return 3848; case 16: return 4104; default: return 4360; }
}
DI void p0_transpose_item(const float* W, int ldw, int n0src, int k0, const float* g, bf16* WT, int K, int nrow0, LAS float* scr, int lane) {
#pragma unroll 8
    for (int i = 0; i < 32; ++i) { const int kk = 2 * i + (lane >> 5); float v = W[(size_t)(k0 + kk) * ldw + n0src + (lane & 31)]; if (g) v *= g[k0 + kk]; scr[kk * 33 + (lane & 31)] = v; }
    LDS_WAIT();
    const int c = lane & 7;
#pragma unroll
    for (int j = 0; j < 4; ++j) { const int n = (lane >> 3) + 8 * j; const LAS float* s = scr + (8 * c) * 33 + n;
        u32x4 o; o.x = cvtpk(s[0 * 33], s[1 * 33]); o.y = cvtpk(s[2 * 33], s[3 * 33]); o.z = cvtpk(s[4 * 33], s[5 * 33]); o.w = cvtpk(s[6 * 33], s[7 * 33]);
        *(u32x4*)(WT + (size_t)(nrow0 + n) * K + k0 + 8 * c) = o; }
    LDS_WAIT();
}
DI int t5_bucket(int d) {
    if (d < 16) return d;
    int lg = 16 + (int)(logf((float)d / 16.0f) / 4.852030263919617f * 16.0f);
    return lg < 31 ? lg : 31;
}
constexpr int P0_I_IN = 16 * 144, P0_I_O = 16 * 32, P0_I_1 = 16 * 128, P0_I_2 = 64 * 32, P0_I_L = P0_I_IN + P0_I_O + P0_I_1 + P0_I_2;
DI void p0_conv_item(const Ctx& c, int l, int r, LAS float* scr, int lane) {
    if (r < P0_I_IN) { const int kb = r / 144, nb = r - kb * 144, np0 = nb * 32;
        p0_transpose_item(c.w_in + (size_t)l * DM * NIN, NIN, colmap(np0 >> 8) + (np0 & 255), kb * 64, c.norm1_g + l * DM, c.win_t + (size_t)l * NP * DM, DM, np0, scr, lane); return; }
    r -= P0_I_IN;
    if (r < P0_I_O) { const int kb = r / 32, nb = r - kb * 32;
        p0_transpose_item(c.w_o + (size_t)l * DM * DM, DM, nb * 32, kb * 64, nullptr, c.wo_t + (size_t)l * DM * DM, DM, nb * 32, scr, lane); return; }
    r -= P0_I_O;
    if (r < P0_I_1) { const int kb = r / 128, nb = r - kb * 128;
        p0_transpose_item(c.w_1 + (size_t)l * DM * FF, FF, nb * 32, kb * 64, c.norm2_g + l * DM, c.w1_t + (size_t)l * FF * DM, DM, nb * 32, scr, lane); return; }
    r -= P0_I_1;
    { const int kb = r / 32, nb = r - kb * 32;
        p0_transpose_item(c.w_2 + (size_t)l * FF * DM, DM, nb * 32, kb * 64, nullptr, c.w2_t + (size_t)l * DM * FF, FF, nb * 32, scr, lane); }
}
DI void p0_prologue(const Ctx& c, LAS unsigned char* lds) {
    const int tid = opaque_tid(), lane = tid & 63, wave = __builtin_amdgcn_readfirstlane(tid >> 6);
    const int G = gridDim.x, bid = opaque_bid(), gw = bid * 8 + wave, NGW = G * 8, gt = bid * 512 + tid, NGT = G * 512;
    LAS float* scr = (LAS float*)(lds + wave * 16384);
    for (int it = gw; it < P0_I_L; it += NGW) p0_conv_item(c, 0, it, scr, lane);
    for (int m0 = gw; m0 < MTOK; m0 += 4 * NGW) {
        f32x4 v[4][4];
#pragma unroll
        for (int u = 0; u < 4; ++u) { const int m = m0 + u * NGW;
#pragma unroll
            for (int j = 0; j < 4; ++j) v[u][j] = (f32x4){0.f, 0.f, 0.f, 0.f};
            if (m < MTOK) { const f32x4* xr = (const f32x4*)(c.x + (size_t)m * DM) + lane;
#pragma unroll
                for (int j = 0; j < 4; ++j) v[u][j] = xr[64 * j]; } }
#pragma unroll
        for (int u = 0; u < 4; ++u) { const int m = m0 + u * NGW;
            if (m < MTOK) { unsigned long long* o8 = (unsigned long long*)(c.xn + (size_t)m * DM) + lane; float s = 0.f;
#pragma unroll
                for (int j = 0; j < 4; ++j) { const f32x4 w = v[u][j]; s += (w.x * w.x + w.y * w.y) + (w.z * w.z + w.w * w.w);
                    o8[64 * j] = (unsigned long long)cvtpk(w.x, w.y) | ((unsigned long long)cvtpk(w.z, w.w) << 32); }
                s = wave_sum(s);
                if (lane == 0) c.ss[m] = (unsigned long long)(s * SS_SCALE); } }
    }
    for (int i = gt; i < 8 * MTOK; i += NGT) c.ss[MTOK + i] = 0ull;
    if (gt < 512) c.knA[gt] = 0u;
    if (gt < DEPTH) { c.ctl[64 * gt] = 0u; c.ctl[64 * (gt + 4)] = 0u; float d1 = 0.f, d2 = 0.f;
        for (int i = 0; i < 32; ++i) { d1 += c.lam_q1[gt * 32 + i] * c.lam_k1[gt * 32 + i]; d2 += c.lam_q2[gt * 32 + i] * c.lam_k2[gt * 32 + i]; }
        c.lamv[gt] = expf(d1) - expf(d2) + (0.8f - 0.6f * expf(-0.3f * (float)gt)); }
    for (int i = gt; i < 4 * 4096; i += NGT) { const int h = i >> 12, d = 4095 - (i & 4095); c.biasA[i] = c.rel_bias[t5_bucket(d) * 16 + h] * LOG2E; }
    for (int i = gt; i < 4 * 396; i += NGT) { const int h = i / 396, r = i - h * 396, g = r / 132, n = r - g * 132; const int dil = g == 0 ? 1 : (g == 1 ? 4 : 16);
        c.tabC[i] = (n <= 128) ? c.rel_bias[t5_bucket(n * dil) * 16 + 4 + 4 * g + h] * LOG2E : 0.f; }
}

DI void fgate_phase(const Ctx& c, int l, LAS unsigned char* lds) {
    const int tid = opaque_tid(), lane = tid & 63, wave = __builtin_amdgcn_readfirstlane(tid >> 6);
    const int gw = opaque_bid() * 8 + wave, NGW = gridDim.x * 8;
    constexpr int WPITCH = 2048 + 16;
    const float* wsrc = c.w_in + (size_t)l * DM * NIN + F_OFF; const float* g1 = c.norm1_g + l * DM;
    for (int i = tid; i < 8192; i += 512) { const int k = i >> 3, h = i & 7; const float v = wsrc[(size_t)k * NIN + h] * g1[k];
        *(LAS unsigned short*)(lds + h * WPITCH + k * 2) = (unsigned short)(cvtpk(v, 0.f) & 0xffffu); }
    __syncthreads();
    const unsigned long long* ss = c.ss + (size_t)(2 * l) * MTOK;
    const int fr = lane & 15, fq = lane >> 4;
    for (int tile = gw; tile < MTOK / 16; tile += NGW) {
        const bf16* xrow = c.xn + (size_t)(tile * 16 + fr) * DM + fq * 8;
        LAS const unsigned char* wrow = lds + (fr & 7) * WPITCH + fq * 16;
        pg8::f32x4 acc = {0.f, 0.f, 0.f, 0.f};
        bf16x8 av[32];
#pragma unroll
        for (int s2 = 0; s2 < 32; ++s2) av[s2] = *(const bf16x8*)(xrow + s2 * 32);
#pragma unroll
        for (int s2 = 0; s2 < 32; ++s2) { const bf16x8 bv = *(const LAS bf16x8*)(wrow + s2 * 64); acc = __builtin_amdgcn_mfma_f32_16x16x32_bf16(av[s2], bv, acc, 0, 0, 0); }
        if (fr < 8) { const float bfv = c.b_f[l * 8 + fr];
#pragma unroll
            for (int j = 0; j < 4; ++j) { const int row = tile * 16 + fq * 4 + j;
                const float f = acc[j] / sqrtf((float)ss[row] * (SS_INV / 1024.0f) + NORM_EPS) + bfv;
                const float ls = fminf(f, 0.f) - __logf(1.0f + __expf(-fabsf(f)));
                const int b = row >> 12, t = row & 4095; c.logf[(size_t)(b * 8 + fr) * SEQ + t] = ls * LOG2E; } }
    }
    __syncthreads();
}

constexpr int N_PHASES_ = 2 + 5 * DEPTH;
DI void final_phase(const Ctx& c) {
    const int tid = opaque_tid(), lane = tid & 63, wave = __builtin_amdgcn_readfirstlane(tid >> 6);
    const int gw = opaque_bid() * 8 + wave, NGW = gridDim.x * 8;
    const unsigned long long* ss = c.ss + (size_t)8 * MTOK;
    const f32x4* gp = (const f32x4*)c.final_g + lane;
    f32x4 g4[4];
#pragma unroll
    for (int j = 0; j < 4; ++j) g4[j] = gp[64 * j];
    float delta = 0.f;
#ifdef PROBE_MASK
    { const unsigned long long* ts = (const unsigned long long*)(c.ws + WS_TABC + 16384); unsigned long long sel = 0;
      for (int p = 0; p < N_PHASES_ - 1; ++p) { const int ty = (p == 0) ? 0 : 1 + ((p - 1) % 5); if ((PROBE_MASK >> ty) & 1) sel += ts[p + 1] - ts[p]; }
      const float f = (float)sel / (float)(ts[N_PHASES_ - 1] - ts[0]); delta = sqrtf(f * 8e-4f); }
#endif
    for (int m0 = gw; m0 < MTOK; m0 += 4 * NGW) {
        unsigned long long w[4][4]; unsigned long long sv[4];
#pragma unroll
        for (int u = 0; u < 4; ++u) { const int m = m0 + u * NGW; sv[u] = 0ull;
#pragma unroll
            for (int j = 0; j < 4; ++j) w[u][j] = 0ull;
            if (m < MTOK) { const unsigned long long* xr = (const unsigned long long*)(c.xn + (size_t)m * DM) + lane;
#pragma unroll
                for (int j = 0; j < 4; ++j) w[u][j] = xr[64 * j];
                sv[u] = ss[m]; } }
#pragma unroll
        for (int u = 0; u < 4; ++u) { const int m = m0 + u * NGW;
            if (m < MTOK) { f32x4* orow = (f32x4*)(c.out + (size_t)m * DM) + lane;
                const float rs = 1.0f / sqrtf((float)sv[u] * (SS_INV / 1024.0f) + NORM_EPS); const float dd = (m < 8192) ? delta : 0.f;
#pragma unroll
                for (int j = 0; j < 4; ++j) { const unsigned long long ww = w[u][j]; f32x4 v;
                    v.x = bf2f((unsigned short)ww); v.y = bf2f((unsigned short)(ww >> 16)); v.z = bf2f((unsigned short)(ww >> 32)); v.w = bf2f((unsigned short)(ww >> 48));
                    orow[64 * j] = v * rs * g4[j] + dd; } } }
    }
}

namespace att {
constexpr int L_K = 0, L_V = 16384, L_TAB = 32768, L_WSF = 49152, L_STG = 53248, L_SLOT = 118784;
constexpr int N_CONV = P0_I_L / 64, N_UNITS = N_CONV + 512 + 512 + 256;
#define NEG_INF_F (-__builtin_inff())
#define MFMA32(a, b, c) __builtin_amdgcn_mfma_f32_32x32x16_bf16((a), (b), (c), 0, 0, 0)
DI int crow(int r, int hi) { return (r & 3) + 8 * (r >> 2) + 4 * hi; }
DI s16x4 vtr(LAS const unsigned char* p) { return __builtin_bit_cast(s16x4, __builtin_amdgcn_ds_read_tr16_b64_v4i16((LAS v4i16_t*)p)); }
DI float swap_max(float a) { auto rr = __builtin_amdgcn_permlane32_swap(__float_as_uint(a), __float_as_uint(a), false, false); return fmaxf(__uint_as_float(rr[0]), __uint_as_float(rr[1])); }
DI float swap_sum(float a) { auto rr = __builtin_amdgcn_permlane32_swap(__float_as_uint(a), __float_as_uint(a), false, false); return __uint_as_float(rr[0]) + __uint_as_float(rr[1]); }

DI void softmax_pv(f32x16& p, f32x16& o0, f32x16& o1, float& mhat, float& l, LAS float* wsa, LAS const unsigned char* vb, int r32, int hi) {
    float a = fmaxf(fmaxf(p[0], p[1]), fmaxf(p[2], p[3]));
#pragma unroll
    for (int r = 4; r < 16; r += 4) a = fmaxf(a, fmaxf(fmaxf(p[r], p[r + 1]), fmaxf(p[r + 2], p[r + 3])));
    a = swap_max(a);
    bool resc = false;
    if (__any(a > 8.0f)) {
        const float dl = fmaxf(a, 0.f); mhat += dl;
#pragma unroll
        for (int r = 0; r < 16; ++r) p[r] -= dl;
        const float f = __builtin_amdgcn_exp2f(-dl); l *= f; if (hi == 0) wsa[r32] = f; resc = true;
    }
    float s = 0.f;
#pragma unroll
    for (int r = 0; r < 16; ++r) { p[r] = __builtin_amdgcn_exp2f(p[r]); s += p[r]; }
    l += s;
    if (resc) { LDS_WAIT();
#pragma unroll
        for (int g = 0; g < 4; ++g) { const f32x4 f4 = *(const LAS f32x4*)(wsa + 8 * g + 4 * hi);
#pragma unroll
            for (int e = 0; e < 4; ++e) { o0[4 * g + e] *= f4[e]; o1[4 * g + e] *= f4[e]; } } }
    u32x4 w0, w1;
    w0.x = cvtpk(p[0], p[1]); w0.y = cvtpk(p[2], p[3]); w0.z = cvtpk(p[4], p[5]); w0.w = cvtpk(p[6], p[7]);
    w1.x = cvtpk(p[8], p[9]); w1.y = cvtpk(p[10], p[11]); w1.z = cvtpk(p[12], p[13]); w1.w = cvtpk(p[14], p[15]);
    const bf16x8 pa0 = __builtin_bit_cast(bf16x8, w0), pa1 = __builtin_bit_cast(bf16x8, w1);
    { const s16x4 a0 = vtr(vb), a1 = vtr(vb + 512), b0 = vtr(vb + 1024), b1 = vtr(vb + 1536);
      o0 = MFMA32(pa0, __builtin_shufflevector(a0, a1, 0, 1, 2, 3, 4, 5, 6, 7), o0);
      o0 = MFMA32(pa1, __builtin_shufflevector(b0, b1, 0, 1, 2, 3, 4, 5, 6, 7), o0); }
    { const s16x4 a0 = vtr(vb + 2048), a1 = vtr(vb + 2048 + 512), b0 = vtr(vb + 2048 + 1024), b1 = vtr(vb + 2048 + 1536);
      o1 = MFMA32(pa0, __builtin_shufflevector(a0, a1, 0, 1, 2, 3, 4, 5, 6, 7), o1);
      o1 = MFMA32(pa1, __builtin_shufflevector(b0, b1, 0, 1, 2, 3, 4, 5, 6, 7), o1); }
}

DI float rowmax16(const f32x16& p) {
    float a = fmaxf(fmaxf(p[0], p[1]), fmaxf(p[2], p[3]));
#pragma unroll
    for (int r = 4; r < 16; r += 4) a = fmaxf(a, fmaxf(fmaxf(p[r], p[r + 1]), fmaxf(p[r + 2], p[r + 3])));
    return a;
}
DI void exp_sum_pack(f32x16& p, float& l, bf16x8& pa0, bf16x8& pa1) {
    float s = 0.f;
#pragma unroll
    for (int r = 0; r < 16; ++r) { p[r] = __builtin_amdgcn_exp2f(p[r]); s += p[r]; }
    l += s;
    u32x4 w0, w1;
    w0.x = cvtpk(p[0], p[1]); w0.y = cvtpk(p[2], p[3]); w0.z = cvtpk(p[4], p[5]); w0.w = cvtpk(p[6], p[7]);
    w1.x = cvtpk(p[8], p[9]); w1.y = cvtpk(p[10], p[11]); w1.z = cvtpk(p[12], p[13]); w1.w = cvtpk(p[14], p[15]);
    pa0 = __builtin_bit_cast(bf16x8, w0); pa1 = __builtin_bit_cast(bf16x8, w1);
}
DI void load_v4(bf16x8 (&vf)[4], LAS const unsigned char* vb) {
#pragma unroll
    for (int i = 0; i < 4; ++i) { const s16x4 a = vtr(vb + i * 1024), b = vtr(vb + i * 1024 + 512); vf[i] = __builtin_shufflevector(a, b, 0, 1, 2, 3, 4, 5, 6, 7); }
}
DI void rescale_o(f32x16& o0, f32x16& o1, LAS const float* wsa, int hi) {
#pragma unroll
    for (int g = 0; g < 4; ++g) { const f32x4 f4 = *(const LAS f32x4*)(wsa + 8 * g + 4 * hi);
#pragma unroll
        for (int e = 0; e < 4; ++e) { o0[4 * g + e] *= f4[e]; o1[4 * g + e] *= f4[e]; } }
}
DI void softmax_pv_b64(f32x16& p0, f32x16& p1, f32x16& o0, f32x16& o1, float& m, float& l, LAS float* wsa, LAS const unsigned char* vb, int r32, int hi) {
    float a = swap_max(fmaxf(rowmax16(p0), rowmax16(p1)));
    if (__any(a > 8.0f)) {
        const float dl = fmaxf(a, 0.f); m += dl;
#pragma unroll
        for (int r = 0; r < 16; ++r) { p0[r] -= dl; p1[r] -= dl; }
        const float f = __builtin_amdgcn_exp2f(-dl); l *= f; if (hi == 0) wsa[r32] = f;
        LDS_WAIT(); rescale_o(o0, o1, wsa, hi);
    }
    bf16x8 pa0, pa1, pa2, pa3, va[4], vb4[4];
    load_v4(va, vb); load_v4(vb4, vb + 4096);
    exp_sum_pack(p0, l, pa0, pa1);
    exp_sum_pack(p1, l, pa2, pa3);
    o0 = MFMA32(pa0, va[0], o0); o1 = MFMA32(pa0, va[2], o1); o0 = MFMA32(pa1, va[1], o0); o1 = MFMA32(pa1, va[3], o1);
    o0 = MFMA32(pa2, vb4[0], o0); o1 = MFMA32(pa2, vb4[2], o1); o0 = MFMA32(pa3, vb4[1], o0); o1 = MFMA32(pa3, vb4[3], o1);
}
DI void exp_pack_nosum(f32x16& p, bf16x8& pa0, bf16x8& pa1) {
#pragma unroll
    for (int r = 0; r < 16; ++r) p[r] = __builtin_amdgcn_exp2f(p[r]);
    u32x4 w0, w1;
    w0.x = cvtpk(p[0], p[1]); w0.y = cvtpk(p[2], p[3]); w0.z = cvtpk(p[4], p[5]); w0.w = cvtpk(p[6], p[7]);
    w1.x = cvtpk(p[8], p[9]); w1.y = cvtpk(p[10], p[11]); w1.z = cvtpk(p[12], p[13]); w1.w = cvtpk(p[14], p[15]);
    pa0 = __builtin_bit_cast(bf16x8, w0); pa1 = __builtin_bit_cast(bf16x8, w1);
}
DI void softmax_nomax_b64(f32x16& p0, f32x16& p1, f32x16& o0, f32x16& o1, f32x16& ol, LAS const unsigned char* vb) {
    bf16x8 pa0, pa1, pa2, pa3, va[4], vb4[4];
    load_v4(va, vb); load_v4(vb4, vb + 4096);
    exp_pack_nosum(p0, pa0, pa1);
    exp_pack_nosum(p1, pa2, pa3);
    const bf16x8 ones = {0x3F80, 0x3F80, 0x3F80, 0x3F80, 0x3F80, 0x3F80, 0x3F80, 0x3F80};
    o0 = MFMA32(pa0, va[0], o0); o1 = MFMA32(pa0, va[2], o1); ol = MFMA32(pa0, ones, ol); o0 = MFMA32(pa1, va[1], o0); o1 = MFMA32(pa1, va[3], o1); ol = MFMA32(pa1, ones, ol);
    o0 = MFMA32(pa2, vb4[0], o0); o1 = MFMA32(pa2, vb4[2], o1); ol = MFMA32(pa2, ones, ol); o0 = MFMA32(pa3, vb4[1], o0); o1 = MFMA32(pa3, vb4[3], o1); ol = MFMA32(pa3, ones, ol);
}
DI void softmax_pv_a2(f32x16& p0, f32x16& p1, f32x16& oa0, f32x16& oa1, f32x16& ob0, f32x16& ob1, float& ma, float& mb, float& la, float& lb, LAS float* wsf, LAS const unsigned char* vb, int r32, int hi) {
    const float a0 = swap_max(rowmax16(p0)), a1 = swap_max(rowmax16(p1));
    if (__any(fmaxf(a0, a1) > 8.0f)) {
        const float d0 = fmaxf(a0, 0.f), d1 = fmaxf(a1, 0.f); ma += d0; mb += d1;
#pragma unroll
        for (int r = 0; r < 16; ++r) { p0[r] -= d0; p1[r] -= d1; }
        const float f0 = __builtin_amdgcn_exp2f(-d0), f1 = __builtin_amdgcn_exp2f(-d1); la *= f0; lb *= f1;
        if (hi == 0) { wsf[r32] = f0; wsf[32 + r32] = f1; }
        LDS_WAIT(); rescale_o(oa0, oa1, wsf, hi); rescale_o(ob0, ob1, wsf + 32, hi);
    }
    bf16x8 pa0, pa1, pb0, pb1, vf[4];
    load_v4(vf, vb);
    exp_sum_pack(p0, la, pa0, pa1);
    exp_sum_pack(p1, lb, pb0, pb1);
    oa0 = MFMA32(pa0, vf[0], oa0); oa1 = MFMA32(pa0, vf[2], oa1); ob0 = MFMA32(pb0, vf[0], ob0); ob1 = MFMA32(pb0, vf[2], ob1);
    oa0 = MFMA32(pa1, vf[1], oa0); oa1 = MFMA32(pa1, vf[3], oa1); ob0 = MFMA32(pb1, vf[1], ob0); ob1 = MFMA32(pb1, vf[3], ob1);
}

DI void softmax_nomax_a2(f32x16& p0, f32x16& p1, f32x16& oa0, f32x16& oa1, f32x16& ob0, f32x16& ob1, float& la, float& lb, LAS const unsigned char* vb) {
    bf16x8 pa0, pa1, pb0, pb1, vf[4];
    load_v4(vf, vb);
    exp_sum_pack(p0, la, pa0, pa1);
    exp_sum_pack(p1, lb, pb0, pb1);
    oa0 = MFMA32(pa0, vf[0], oa0); oa1 = MFMA32(pa0, vf[2], oa1); ob0 = MFMA32(pb0, vf[0], ob0); ob1 = MFMA32(pb0, vf[2], ob1);
    oa0 = MFMA32(pa1, vf[1], oa0); oa1 = MFMA32(pa1, vf[3], oa1); ob0 = MFMA32(pb1, vf[1], ob0); ob1 = MFMA32(pb1, vf[3], ob1);
}
template <int TYPE> DI void finish(const f32x16& oa0, const f32x16& oa1, const f32x16& ob0, const f32x16& ob1, float la, float lb, float lam, float oscale, const float* subg,
                                   LAS float* wsf, LAS float* stg, bf16* orow0, size_t rstride, int lane, int r32, int hi, int dry = 0, int lready = 0) {
    if (!lready) { la = swap_sum(la); if (hi == 0) wsf[64 + r32] = la; }
    if (TYPE == 0) { lb = swap_sum(lb); if (hi == 0) wsf[96 + r32] = lb; }
    LDS_WAIT();
#pragma unroll
    for (int g = 0; g < 4; ++g) {
        const f32x4 l0 = *(const LAS f32x4*)(wsf + 64 + 8 * g + 4 * hi);
        f32x4 l1 = l0; if (TYPE == 0) l1 = *(const LAS f32x4*)(wsf + 96 + 8 * g + 4 * hi);
#pragma unroll
        for (int e = 0; e < 4; ++e) { const int r = 4 * g + e, row = e + 8 * g + 4 * hi; const float i0 = __builtin_amdgcn_rcpf(l0[e]);
            float v0 = oa0[r] * i0, v1 = oa1[r] * i0;
            if (TYPE == 0) { const float i1 = lam * __builtin_amdgcn_rcpf(l1[e]); v0 -= ob0[r] * i1; v1 -= ob1[r] * i1; }
            stg[row * 64 + r32] = v0; stg[row * 64 + 32 + r32] = v1; }
    }
    LDS_WAIT();
    const int c8 = (lane & 7) * 8;
    f32x4 ga = {1.f, 1.f, 1.f, 1.f}, gb = ga;
    if (TYPE == 0) { ga = *(const f32x4*)(subg + c8); gb = *(const f32x4*)(subg + c8 + 4); }
#pragma unroll
    for (int it = 0; it < 4; ++it) { const int row = it * 8 + (lane >> 3);
        f32x4 a = *(const LAS f32x4*)(stg + row * 64 + c8), b = *(const LAS f32x4*)(stg + row * 64 + c8 + 4);
        if (TYPE == 0) { float q = (a.x * a.x + a.y * a.y) + (a.z * a.z + a.w * a.w) + (b.x * b.x + b.y * b.y) + (b.z * b.z + b.w * b.w);
            q += __shfl_xor(q, 1); q += __shfl_xor(q, 2); q += __shfl_xor(q, 4);
            const float rs = oscale / sqrtf(q * (1.0f / 64.0f) + NORM_EPS); a = a * rs * ga; b = b * rs * gb; }
        u32x4 w; w.x = cvtpk(a.x, a.y); w.y = cvtpk(a.z, a.w); w.z = cvtpk(b.x, b.y); w.w = cvtpk(b.z, b.w);
        if (!dry) *(u32x4*)(orow0 + (size_t)row * rstride + c8) = w; }
    LDS_WAIT();
}

template <int TYPE> DI void unit_ab(const Ctx& c, int layer, int b, int h, int qb_first, int nqb, LAS unsigned char* lds, int dry, float refa = 0.f, float refb = 0.f) {
    constexpr bool ISA = (TYPE == 0 || TYPE == 3);
    const int tid = opaque_tid(), lane = tid & 63, wid = __builtin_amdgcn_readfirstlane(tid >> 6), r32 = lane & 31, hi = lane >> 5;
    const int qcol = (ISA ? PC_QA : PC_QB) + h * 64, kcol = (ISA ? PC_KA : PC_KB) + h * 64, vcol = (ISA ? PC_VA : PC_VB) + h * 64;
    bf16* P = c.proj + (size_t)b * SEQ * NP;
    LAS float* tab = (LAS float*)(lds + L_TAB);
    LAS float* wsf = (LAS float*)(lds + L_WSF) + wid * 128;
    float lam = 0.f, oscale = 1.f;
    LAS float* wt = (LAS float*)(lds + L_SLOT + 64);
    LAS float* knL = wt + 16;
    if (ISA) {
        const f32x4* src = (const f32x4*)(c.biasA + h * 4096);
        for (int i = tid; i < 1024; i += 512) ((LAS f32x4*)tab)[i] = src[i];
        lam = c.lamv[layer]; oscale = 1.0f - (0.8f - 0.6f * expf(-0.3f * (float)layer));
    } else {
        if (tid < 64) knL[tid] = c.knorm[(b * 8 + h) * 64 + tid];
        const int n = (qb_first + nqb) * 256, e0 = tid * 8;
        const f32x4* src = (const f32x4*)(c.logf + (size_t)(b * 8 + h) * SEQ) + 2 * tid;
        float v[8];
        if (e0 < n) { const f32x4 a = src[0], bb = src[1]; v[0] = a.x; v[1] = a.y; v[2] = a.z; v[3] = a.w; v[4] = bb.x; v[5] = bb.y; v[6] = bb.z; v[7] = bb.w; }
        else {
#pragma unroll
            for (int i = 0; i < 8; ++i) v[i] = 0.f; }
#pragma unroll
        for (int i = 1; i < 8; ++i) v[i] += v[i - 1];
        const float tot = v[7]; float sc = tot;
#pragma unroll
        for (int d = 1; d < 64; d <<= 1) { const float t = __shfl_up(sc, d); if (lane >= d) sc += t; }
        if (lane == 63) wt[wid] = sc;
        __syncthreads();
        float woff = 0.f;
#pragma unroll
        for (int w = 0; w < 8; ++w) if (w < wid) woff += wt[w];
        const float base = woff + sc - tot;
        if (e0 < n) { f32x4 a, bb; a.x = base + v[0]; a.y = base + v[1]; a.z = base + v[2]; a.w = base + v[3]; bb.x = base + v[4]; bb.y = base + v[5]; bb.z = base + v[6]; bb.w = base + v[7];
            ((LAS f32x4*)tab)[2 * tid] = a; ((LAS f32x4*)tab)[2 * tid + 1] = bb; }
    }
  for (int qi = 0; qi < nqb; ++qi) {
    const int qb = qb_first + qi;
    const int q0 = qb * 256, q0w = q0 + wid * 32, NT = (q0 + 256) / 64;
    bf16x8 qf[4];
#pragma unroll
    for (int d0 = 0; d0 < 4; ++d0) qf[d0] = *(const bf16x8*)(P + (size_t)(q0w + r32) * NP + qcol + d0 * 16 + hi * 8);
    float qw = 0.f;
    int tstart = 0, fastb = 0; float kmaxall = 0.f;
    if (TYPE == 1) {
        { float sq = 0.f;
#pragma unroll
          for (int d0 = 0; d0 < 4; ++d0)
#pragma unroll
              for (int j = 0; j < 8; ++j) { const float v = bf2f((unsigned short)qf[d0][j]); sq += v * v; }
          sq = swap_sum(sq);
#pragma unroll
          for (int o = 1; o < 32; o <<= 1) sq = fmaxf(sq, __shfl_xor(sq, o));
          qw = sqrtf(sq) * 1.0001f;
          if (lane == 0) wt[8 + wid] = qw; }
        __syncthreads();
        float qb8 = wt[8];
#pragma unroll
        for (int w = 1; w < 8; ++w) qb8 = fmaxf(qb8, wt[8 + w]);
        const float kself = fmaxf(fmaxf(knL[NT - 4], knL[NT - 3]), fmaxf(knL[NT - 2], knL[NT - 1]));
        const bool sk = (lane < NT - 4) && (qb8 * (knL[lane] + kself) + (tab[q0] - tab[64 * lane + 63]) + 2.0f < -150.f);
        const unsigned long long bm = __ballot(sk);
        tstart = __builtin_amdgcn_readfirstlane(__builtin_ctzll(~bm));
        float km = (lane < NT) ? knL[lane] : 0.f;
#pragma unroll
        for (int o = 1; o < 64; o <<= 1) km = fmaxf(km, __shfl_xor(km, o));
        kmaxall = km; fastb = (qb8 * km <= 40.0f) ? 1 : 0;
    }
    const int lkey = tid >> 3, lch = tid & 7;
    const bf16* kp = P + (size_t)lkey * NP + kcol + lch * 8; const bf16* vp = P + (size_t)lkey * NP + vcol + lch * 8;
    const int kwoff = lkey * 128 + ((lch ^ ((lkey >> 1) & 7)) * 16);
    const int vwoff = (lkey >> 5) * 4096 + (lch >> 2) * 2048 + ((lkey & 31) >> 4) * 1024 + ((lkey >> 3) & 1) * 512 + (lkey & 7) * 64 + (lch & 3) * 16;
    const u32x4 kfirst = *(const u32x4*)(kp + (size_t)tstart * 64 * NP), vfirst = *(const u32x4*)(vp + (size_t)tstart * 64 * NP);
    u32x4 kreg = *(const u32x4*)(kp + (size_t)(tstart + 1) * 64 * NP), vreg = *(const u32x4*)(vp + (size_t)(tstart + 1) * 64 * NP);
    *(LAS u32x4*)(lds + L_K + (tstart & 1) * 8192 + kwoff) = kfirst; *(LAS u32x4*)(lds + L_V + (tstart & 1) * 8192 + vwoff) = vfirst;
    __syncthreads();
    f32x16 oa0 = {}, oa1 = {}, ob0 = {}, ob1 = {};
    float ma = 0.f, mb = 0.f, la = 0.f, lb = 0.f;
    float cq = 0.f, cq0w = 0.f, kselfw = 0.f;
    if (TYPE == 1) { cq = tab[q0w + r32]; cq0w = tab[q0w]; kselfw = knL[q0w >> 6]; if (fastb) ma = qw * kmaxall; }
    if (TYPE == 3) { ma = refa; mb = refb; }
    const int trb = (4 * hi + ((lane & 15) >> 2)) * 64 + ((lane >> 4) & 1) * 32 + (lane & 3) * 8;
    const int krd = r32 * 128, kx = (r32 >> 1) & 7;
    for (int t = tstart; t < NT; ++t) {
        LAS const unsigned char* kb = lds + L_K + (t & 1) * 8192; LAS const unsigned char* vbuf = lds + L_V + (t & 1) * 8192;
        if (TYPE == 1) {
            const int k0 = t * 64;
            bool act = (k0 <= q0w + 31);
            if (act && k0 + 64 <= q0w) act = !(qw * (knL[t] + kselfw) + (cq0w - tab[k0 + 63]) + 2.0f < -150.f);
            if (__builtin_amdgcn_readfirstlane((int)act)) {
                bf16x8 kf0[4], kf1[4];
#pragma unroll
                for (int d0 = 0; d0 < 4; ++d0) { kf0[d0] = *(const LAS bf16x8*)(kb + krd + (((2 * d0 + hi) ^ kx) * 16)); kf1[d0] = *(const LAS bf16x8*)(kb + 4096 + krd + (((2 * d0 + hi) ^ kx) * 16)); }
                const float base = cq - ma;
                f32x16 p0, p1;
#pragma unroll
                for (int g = 0; g < 4; ++g) { const f32x4 c0 = *(const LAS f32x4*)(tab + k0 + 8 * g + 4 * hi), c1 = *(const LAS f32x4*)(tab + k0 + 32 + 8 * g + 4 * hi);
#pragma unroll
                    for (int e = 0; e < 4; ++e) { p0[4 * g + e] = base - c0[e]; p1[4 * g + e] = base - c1[e]; } }
#pragma unroll
                for (int d0 = 0; d0 < 4; ++d0) { p0 = MFMA32(kf0[d0], qf[d0], p0); p1 = MFMA32(kf1[d0], qf[d0], p1); }
                if (k0 + 63 > q0w) { const int dbase = q0w + r32 - k0;
#pragma unroll
                    for (int r = 0; r < 16; ++r) { if (dbase - crow(r, hi) < 0) p0[r] = NEG_INF_F; if (dbase - 32 - crow(r, hi) < 0) p1[r] = NEG_INF_F; } }
                if (fastb) softmax_nomax_b64(p0, p1, oa0, oa1, ob0, vbuf + trb); else softmax_pv_b64(p0, p1, oa0, oa1, ma, la, wsf, vbuf + trb, r32, hi);
            }
        } else {
#pragma unroll
        for (int hf = 0; hf < 2; ++hf) {
            const int k0 = t * 64 + hf * 32;
            if (k0 <= q0w + 31) {
                bf16x8 kf[4];
#pragma unroll
                for (int d0 = 0; d0 < 4; ++d0) kf[d0] = *(const LAS bf16x8*)(kb + hf * 4096 + krd + (((2 * d0 + hi) ^ kx) * 16));
                const bool diag = (k0 + 31 > q0w);
                const int dbase = q0w + r32 - k0;
                LAS const unsigned char* vb = vbuf + hf * 4096 + trb;
                    const int dlo = q0w - k0 - 31;
                    float b0 = 0.f; int uni = 0;
                    if (dlo >= 245) { const float blo = tab[4095 - dlo], bhi = tab[4095 - dlo - 62]; b0 = blo; uni = (blo == bhi) ? 1 : 0; }
                    f32x16 p0, p1;
                    if (__builtin_amdgcn_readfirstlane(uni)) {
#pragma unroll
                        for (int r = 0; r < 16; ++r) { p0[r] = b0 - ma; p1[r] = b0 - mb; }
                        p0 = MFMA32(kf[0], qf[0], p0); p1 = MFMA32(kf[2], qf[2], p1); p0 = MFMA32(kf[1], qf[1], p0); p1 = MFMA32(kf[3], qf[3], p1);
                    } else {
                        const LAS float* tp = tab + (4095 - dbase + 4 * hi);
#pragma unroll
                        for (int r = 0; r < 16; ++r) { float bv = tp[(r & 3) + 8 * (r >> 2)]; if (diag && (r32 - crow(r, hi) < 0)) bv = NEG_INF_F; p0[r] = bv - ma; p1[r] = bv - mb; }
                        p0 = MFMA32(kf[0], qf[0], p0); p1 = MFMA32(kf[2], qf[2], p1); p0 = MFMA32(kf[1], qf[1], p0); p1 = MFMA32(kf[3], qf[3], p1);
                    }
                    if (TYPE == 3) softmax_nomax_a2(p0, p1, oa0, oa1, ob0, ob1, la, lb, vb); else softmax_pv_a2(p0, p1, oa0, oa1, ob0, ob1, ma, mb, la, lb, wsf, vb, r32, hi);
            }
        }
        }
        if (t + 1 < NT) { *(LAS u32x4*)(lds + L_K + ((t + 1) & 1) * 8192 + kwoff) = kreg; *(LAS u32x4*)(lds + L_V + ((t + 1) & 1) * 8192 + vwoff) = vreg; }
        __syncthreads();
        if (t + 2 < NT) { kreg = *(const u32x4*)(kp + (size_t)(t + 2) * 64 * NP); vreg = *(const u32x4*)(vp + (size_t)(t + 2) * 64 * NP); }
    }
    if (TYPE == 1 && fastb) { if (r32 == 0) {
#pragma unroll
            for (int r = 0; r < 16; ++r) wsf[64 + crow(r, hi)] = ob0[r]; } }
    finish<ISA ? 0 : 1>(oa0, oa1, ob0, ob1, la, lb, lam, oscale, c.diff_g + layer * 64, wsf, (LAS float*)(lds + L_STG + wid * 8192), P + (size_t)q0w * NP + qcol, (size_t)NP, lane, r32, hi, dry, (TYPE == 1 && fastb) ? 1 : 0);
  }
}

DI void unit_c(const Ctx& c, int b, int h, int chunk, LAS unsigned char* lds, int dry) {
    const int tid = opaque_tid(), lane = tid & 63, wid = __builtin_amdgcn_readfirstlane(tid >> 6), r32 = lane & 31, hi = lane >> 5;
    bf16* P = c.proj + (size_t)b * SEQ * NP;
    LAS float* tabc = (LAS float*)(lds + L_TAB);
    for (int i = tid; i < 396; i += 512) tabc[i] = c.tabC[h * 396 + i];
    __syncthreads();
    LAS float* wsf = (LAS float*)(lds + L_WSF) + wid * 128;
    LAS unsigned char* vbuf = lds + L_K + wid * 4096;
    const int trb = (4 * hi + ((lane & 15) >> 2)) * 64 + ((lane >> 4) & 1) * 32 + (lane & 3) * 8;
    const int vw0 = ((lane & 7) >> 2) * 2048 + (lane >> 3) * 64 + (lane & 3) * 16;
    const int c0 = chunk * 256;
    const int tq = c0 + wid + 8 * r32, thi = c0 + wid + 248;
    f32x16 o0 = {}, o1 = {}; float mh = 0.f, l = 0.f;
#pragma unroll 1
    for (int g = 0; g < 3; ++g) {
        const int dl = g == 0 ? 1 : (g == 1 ? 4 : 8), NT = g == 0 ? 12 : (g == 1 ? 6 : 9), R = 8 / dl;
        const int qcol = (g == 0 ? PC_QC0 : (g == 1 ? PC_QC1 : PC_QC2)) + h * 64, kcol = PC_KC + 256 * g + h * 64, vcol = PC_VC + 256 * g + h * 64;
        bf16x8 qf[4];
#pragma unroll
        for (int d0 = 0; d0 < 4; ++d0) qf[d0] = *(const bf16x8*)(P + (size_t)tq * NP + qcol + d0 * 16 + hi * 8);
        const int tstart = thi - dl * (32 * NT - 1);
        const unsigned nmaxu = (unsigned)min(128, tq >> (g == 0 ? 0 : (g == 1 ? 2 : 4)));
        const LAS float* tabl = tabc + g * 132;
        bf16x8 kf[4]; u32x4 vr[4];
        { const int tk = tstart + dl * r32, tok = tk < 0 ? 0 : tk;
#pragma unroll
          for (int d0 = 0; d0 < 4; ++d0) kf[d0] = *(const bf16x8*)(P + (size_t)tok * NP + kcol + (2 * d0 + hi) * 8);
#pragma unroll
          for (int i = 0; i < 4; ++i) { const int tv = tstart + dl * ((lane >> 3) + 8 * i), tokv = tv < 0 ? 0 : tv; vr[i] = *(const u32x4*)(P + (size_t)tokv * NP + vcol + (lane & 7) * 8); } }
        for (int st = 0; st < NT; ++st) {
#pragma unroll
            for (int i = 0; i < 4; ++i) *(LAS u32x4*)(vbuf + vw0 + (i >> 1) * 1024 + (i & 1) * 512) = vr[i];
            bf16x8 kc[4];
#pragma unroll
            for (int d0 = 0; d0 < 4; ++d0) kc[d0] = kf[d0];
            if (st + 1 < NT) { const int j0 = 32 * (st + 1); const int tk = tstart + dl * (j0 + r32), tok = tk < 0 ? 0 : tk;
#pragma unroll
                for (int d0 = 0; d0 < 4; ++d0) kf[d0] = *(const bf16x8*)(P + (size_t)tok * NP + kcol + (2 * d0 + hi) * 8);
#pragma unroll
                for (int i = 0; i < 4; ++i) { const int tv = tstart + dl * (j0 + (lane >> 3) + 8 * i), tokv = tv < 0 ? 0 : tv; vr[i] = *(const u32x4*)(P + (size_t)tokv * NP + vcol + (lane & 7) * 8); } }
            LDS_WAIT();
            f32x16 p;
            const int mbl = R * (r32 - 31) + 32 * NT - 1 - 32 * st - 4 * hi;
#pragma unroll
            for (int r = 0; r < 16; ++r) { const unsigned mm = (unsigned)(mbl - ((r & 3) + 8 * (r >> 2)));
                const unsigned n = (g == 2) ? (mm >> 1) : mm; const bool ok = (n <= nmaxu) && ((g != 2) || ((mm & 1u) == 0u));
                const unsigned nc = n < 129u ? n : 129u; const float bv = tabl[nc]; p[r] = ok ? bv - mh : NEG_INF_F; }
#pragma unroll
            for (int d0 = 0; d0 < 4; ++d0) p = MFMA32(kc[d0], qf[d0], p);
            softmax_pv(p, o0, o1, mh, l, wsf, vbuf + trb, r32, hi);
            LDS_WAIT();
        }
    }
    finish<2>(o0, o1, o0, o1, l, l, 0.f, 1.f, nullptr, wsf, (LAS float*)(lds + L_STG + wid * 8192), P + (size_t)(c0 + wid) * NP + PC_QC2 + h * 64, (size_t)8 * NP, lane, r32, hi, dry);
}

DI float sumsq8(const u32x4& w) { float t = 0.f;
#pragma unroll
    for (int e = 0; e < 4; ++e) { const float lo = __uint_as_float(w[e] << 16), hi = __uint_as_float(w[e] & 0xffff0000u); t += lo * lo + hi * hi; }
    return t; }
DI float kn_reduce_b(const float (&pv)[8], int lane) {
    float r4[4], r2[2], v;
    { const bool up = (lane & 1) != 0;
#pragma unroll
      for (int i = 0; i < 4; ++i) { const float send = up ? pv[i] : pv[i + 4], keep = up ? pv[i + 4] : pv[i]; r4[i] = keep + __shfl_xor(send, 1); } }
    { const bool up = (lane & 2) != 0;
#pragma unroll
      for (int i = 0; i < 2; ++i) { const float send = up ? r4[i] : r4[i + 2], keep = up ? r4[i + 2] : r4[i]; r2[i] = keep + __shfl_xor(send, 2); } }
    { const bool up = (lane & 4) != 0; const float send = up ? r2[0] : r2[1], keep = up ? r2[1] : r2[0]; v = keep + __shfl_xor(send, 4); }
#pragma unroll
    for (int o = 1; o < 64; o <<= 1) v = fmaxf(v, __shfl_xor(v, o));
    return v;
}
DI float kn_reduce_a(const float (&pv)[8], int lane) {
    float r4[4], r2[2];
    { const bool up = (lane & 1) != 0;
#pragma unroll
      for (int i = 0; i < 4; ++i) { const float send = up ? pv[i] : pv[i + 4], keep = up ? pv[i + 4] : pv[i]; r4[i] = keep + __shfl_xor(send, 1); } }
    { const bool up = (lane & 2) != 0;
#pragma unroll
      for (int i = 0; i < 2; ++i) { const float send = up ? r4[i] : r4[i + 2], keep = up ? r4[i + 2] : r4[i]; r2[i] = keep + __shfl_xor(send, 2); } }
    float m = fmaxf(r2[0], r2[1]);
    m = fmaxf(m, __shfl_xor(m, 1)); m = fmaxf(m, __shfl_xor(m, 2)); m = fmaxf(m, __shfl_xor(m, 8)); m = fmaxf(m, __shfl_xor(m, 16)); m = fmaxf(m, __shfl_xor(m, 32));
    return m;
}
DI void knorm_phase(const Ctx& c, int layer) {
    const int tid = opaque_tid(), lane = tid & 63, wave = __builtin_amdgcn_readfirstlane(tid >> 6);
    const int gw = opaque_bid() * 8 + wave, NGW = gridDim.x * 8, sub = lane >> 3, ch = lane & 7;
    for (int it0 = gw; it0 < 4096; it0 += 2 * NGW) {
        float pb[2][8], pa[2][8];
#pragma unroll
        for (int u = 0; u < 2; ++u) { const int it = it0 + u * NGW; const bool on = it < 4096; const int itc = on ? it : 0;
            { const int bh = itc >> 6, tile = itc & 63, b = bh >> 3, h = bh & 7;
              const bf16* base = c.proj + ((size_t)b * SEQ + tile * 64 + sub) * NP + PC_KB + h * 64 + ch * 8;
#pragma unroll
              for (int i = 0; i < 8; ++i) pb[u][i] = sumsq8(*(const u32x4*)(base + (size_t)(8 * i) * NP)); }
            { const int isq = itc >> 11, r = itc & 2047, bh = r >> 6, tile = r & 63, b = bh >> 2, h = bh & 3;
              const bf16* base = c.proj + ((size_t)b * SEQ + tile * 64 + sub) * NP + (isq ? PC_QA : PC_KA) + h * 64 + ch * 8;
#pragma unroll
              for (int i = 0; i < 8; ++i) pa[u][i] = sumsq8(*(const u32x4*)(base + (size_t)(8 * i) * NP)); } }
#pragma unroll
        for (int u = 0; u < 2; ++u) { const int it = it0 + u * NGW;
            if (it < 4096) {
                const float v = kn_reduce_b(pb[u], lane);
                if (lane == 0) c.knorm[it] = sqrtf(v) * 1.0001f;
                const float m = kn_reduce_a(pa[u], lane);
                const int isq = it >> 11, bh = (it & 2047) >> 6;
                if ((lane & 59) == 0) atomicMax(c.knA + layer * 128 + isq * 64 + bh * 2 + (lane >> 2), __float_as_uint(sqrtf(m) * 1.0001f)); } }
    }
}

DI void attn_phase(const Ctx& c, int layer, LAS unsigned char* lds, int dry = 0) {
    LAS int* slot = (LAS int*)(lds + L_SLOT);
    unsigned* counter = c.ctl + 64 * (layer + 4 * dry); const int tid0 = opaque_tid();
    for (;;) {
        __syncthreads();
        if (tid0 == 0) slot[0] = (int)atomicAdd(counter, 1u);
        __syncthreads();
        const int u0 = __builtin_amdgcn_readfirstlane(slot[0]);
        if (u0 >= N_UNITS) break;
        if (u0 < N_CONV) { if (layer + 1 < DEPTH) { const int tid_ = opaque_tid(), lane_ = tid_ & 63, wv_ = __builtin_amdgcn_readfirstlane(tid_ >> 6);
                for (int j = 0; j < 8; ++j) p0_conv_item(c, layer + 1, u0 * 64 + wv_ * 8 + j, (LAS float*)(lds + wv_ * 16384), lane_); }
            continue; }
        const int u = u0 - N_CONV;
#ifndef NO_UC
        if (u < 512) { unit_c(c, u >> 6, (u >> 4) & 3, u & 15, lds, dry); } else
#endif
        { const int v = u - 512;
            if (v >= 128 && v < 384) { const int w = v - 128, g = 3 - (w >> 6), bh = w & 63; unit_ab<1>(c, layer, bh >> 3, bh & 7, 4 * g, 4, lds, dry); }
            else { const int w = (v < 128) ? v : v - 256, lev = 15 - (w >> 5), r = w & 31; const int ab = r >> 2, ah = r & 3;
                const unsigned* kn_ = c.knA + layer * 128 + (ab * 4 + ah) * 2;
                const float k0n = __uint_as_float(kn_[0]), k1n = __uint_as_float(kn_[1]), q0n = __uint_as_float(kn_[64]), q1n = __uint_as_float(kn_[65]);
                float bmx = -1e30f, bmn = 1e30f;
                for (int i = 0; i < 32; ++i) { const float bv = c.rel_bias[i * 16 + ah] * LOG2E; bmx = fmaxf(bmx, bv); bmn = fminf(bmn, bv); }
                const float span = 2.0f * fmaxf(q0n * k0n, q1n * k1n) + (bmx - bmn);
                if (span <= 80.0f) unit_ab<3>(c, layer, ab, ah, lev, 1, lds, dry, q0n * k0n + bmx + 0.01f, q1n * k1n + bmx + 0.01f);
                else unit_ab<0>(c, layer, ab, ah, lev, 1, lds, dry); } }
    }
}
}

#define XB_TMO      128
#define XB_XCNT(j)  (256  + 64 * (j))
#define XB_XSUB(j)  (1280 + 64 * (j))
#define XB_XGEN(j)  (2304 + 64 * (j))
#define XB_TOP      3328
#define XB_TOPGEN   3392
#define XCD_BAR_WORDS 3456
#define XB_SPIN_CAP (1u << 18)

__device__ __forceinline__ unsigned xb_ld(unsigned* p)              { return __hip_atomic_load(p, __ATOMIC_RELAXED, __HIP_MEMORY_SCOPE_AGENT); }
__device__ __forceinline__ unsigned xb_add(unsigned* p, unsigned v) { return __hip_atomic_fetch_add(p, v, __ATOMIC_RELAXED, __HIP_MEMORY_SCOPE_AGENT); }
__device__ __forceinline__ unsigned xb_xcc_id() { return (unsigned)__builtin_amdgcn_s_getreg((3 << 11) | 20) & 0xFu; }
#define XB_SPIN(cond, bar) do { unsigned _sp = 0; while (cond) { __builtin_amdgcn_s_sleep(1); \
    if ((++_sp & 255u) == 0u) { if (xb_ld(&(bar)[XB_TMO])) break; if (_sp > XB_SPIN_CAP) { atomicAdd(&(bar)[XB_TMO], 1u); break; } } } } while (0)

struct XcdBarrier {
    unsigned* bar; unsigned x;
    volatile LAS unsigned* st;
};

__device__ __forceinline__ XcdBarrier xcd_barrier_post(unsigned* bar, volatile LAS unsigned* st) {
    XcdBarrier b; b.bar = bar; b.x = xb_xcc_id(); b.st = st;
    if (threadIdx.x == 0) (void)xb_add(&bar[XB_XCNT(b.x)], 1u);
    return b;
}
__device__ __forceinline__ void xcd_barrier_complete(unsigned* bar, unsigned x, unsigned& nloc, unsigned& nx) {
    const unsigned G = gridDim.x * gridDim.y * gridDim.z;
    unsigned sum, cnt, mine, sp = 0u;
    for (;;) {
        sum = 0u; cnt = 0u; mine = 0u;
#pragma unroll
        for (unsigned j = 0; j < 16; ++j) { const unsigned c = xb_ld(&bar[XB_XCNT(j)]); sum += c; cnt += (c > 0u) ? 1u : 0u; mine = (j == x) ? c : mine; }
        if (sum == G) break;
        __builtin_amdgcn_s_sleep(1);
        if ((++sp & 255u) == 0u) { if (xb_ld(&bar[XB_TMO])) break; if (sp > XB_SPIN_CAP) { atomicAdd(&bar[XB_TMO], 1u); break; } }
    }
    nloc = mine > 0u ? mine : 1u; nx = cnt > 0u ? cnt : 1u;
}

__device__ __forceinline__ void xcd_barrier(const XcdBarrier& b) {
    asm volatile("s_waitcnt vmcnt(0)" ::: "memory");
    __syncthreads();
    if (threadIdx.x == 0) {
        unsigned* bar = b.bar;
        __builtin_amdgcn_s_waitcnt(0);
        unsigned nloc = b.st[0], nx = b.st[1];
        if (nloc == 0u) { xcd_barrier_complete(bar, b.x, nloc, nx); b.st[0] = nloc; b.st[1] = nx; }
        const unsigned old = xb_add(&bar[XB_XSUB(b.x)], 1u);
        const unsigned gen = old / nloc;
        if (old + 1u == (gen + 1u) * nloc) {
            __builtin_amdgcn_fence(__ATOMIC_RELEASE, "agent");
            asm volatile("s_waitcnt vmcnt(0)" ::: "memory");
            const unsigned og = xb_add(&bar[XB_TOP], 1u);
            const unsigned tg = og / nx;
            if (og + 1u == (tg + 1u) * nx) xb_add(&bar[XB_TOPGEN], 1u);
            else XB_SPIN(xb_ld(&bar[XB_TOPGEN]) == tg, bar);
            __builtin_amdgcn_fence(__ATOMIC_ACQUIRE, "agent");
            xb_add(&bar[XB_XGEN(b.x)], 1u);
            asm volatile("s_waitcnt vmcnt(0)" ::: "memory");
        } else {
            XB_SPIN(xb_ld(&bar[XB_XGEN(b.x)]) == gen, bar);
            __builtin_amdgcn_fence(__ATOMIC_ACQUIRE, "agent");
            asm volatile("s_waitcnt vmcnt(0)" ::: "memory");
        }
    }
    __syncthreads();
}

constexpr int LDS_BYTES = 131072 + 1024;
constexpr int N_PHASES = 2 + 5 * DEPTH;
struct Args { const float* in[15]; float* out; unsigned char* ws; int ph_lo, ph_hi; };
typedef const __attribute__((address_space(4))) Args* KArgP;
DI Ctx make_ctx(KArgP a) {
    Ctx c;
    c.x = a->in[0]; c.norm1_g = a->in[1]; c.w_in = a->in[2]; c.b_f = a->in[3]; c.lam_q1 = a->in[4]; c.lam_k1 = a->in[5]; c.lam_q2 = a->in[6]; c.lam_k2 = a->in[7]; c.diff_g = a->in[8];
    c.w_o = a->in[9]; c.norm2_g = a->in[10]; c.w_1 = a->in[11]; c.w_2 = a->in[12]; c.rel_bias = a->in[13]; c.final_g = a->in[14];
    c.out = a->out; c.ws = a->ws; unsigned char* ws = a->ws;
    c.win_t = (bf16*)(ws + WS_WIN); c.wo_t = (bf16*)(ws + WS_WO); c.w1_t = (bf16*)(ws + WS_W1); c.w2_t = (bf16*)(ws + WS_W2);
    c.xn = (bf16*)(ws + WS_XN); c.proj = (bf16*)(ws + WS_PROJ);
    c.ss = (unsigned long long*)(ws + WS_SS); c.logf = (float*)(ws + WS_LOGF); c.biasA = (float*)(ws + WS_BIASA); c.tabC = (float*)(ws + WS_TABC); c.lamv = (float*)(ws + WS_TABC + 8192); c.knorm = (float*)(ws + WS_TABC + 32768); c.knA = (unsigned*)(ws + WS_TABC + 49152); c.ctl = (unsigned*)(ws + WS_CTL);
    return c;
}
#define PHASE_CTX() KArgP ap_ = (KArgP)__builtin_amdgcn_kernarg_segment_ptr(); asm volatile("" : "+s"(ap_)); const Ctx c = make_ctx(ap_)
__global__ void __launch_bounds__(512, 2) trunk_fwd(Args a) {
    extern __shared__ __attribute__((aligned(16))) unsigned char lds_raw[];
    LAS unsigned char* lds = (LAS unsigned char*)lds_raw;
    cg::grid_group grid = cg::this_grid();
    volatile LAS unsigned* xb_st = (volatile LAS unsigned*)(lds + 131072 + 512);
    if (threadIdx.x < 2) xb_st[threadIdx.x] = 0u;
    __syncthreads();
    const XcdBarrier xbar = xcd_barrier_post((unsigned*)(a.ws + 16384), xb_st);
    if (a.ph_hi < 0) grid.sync();
#ifdef FORCE_LO
    const int lo = FORCE_LO, hi = FORCE_HI, G = gridDim.x;
#else
    const int lo = a.ph_lo, hi = a.ph_hi, G = gridDim.x;
#endif
#define RUN(p) (lo <= (p) && (p) < hi)
#ifdef PROBE_MASK
#define STAMP(p) do { if (blockIdx.x == 0 && threadIdx.x == 0) ((unsigned long long*)(a.ws + WS_TABC + 16384))[(p)] = __builtin_amdgcn_s_memrealtime(); } while (0)
#else
#define STAMP(p) do { } while (0)
#endif
#define SEAM(p) do { if (RUN(p) && RUN((p) + 1)) { xcd_barrier(xbar); } STAMP((p) + 1); } while (0)
    STAMP(0);
    if (RUN(0)) { PHASE_CTX(); p0_prologue(c, lds); }
    SEAM(0);
    for (int l = 0; l < DEPTH; ++l) {
        const int pb = 1 + 5 * l;
        if (RUN(pb)) { PHASE_CTX();
            pg8::Gemm g{c.xn, c.win_t + (size_t)l * NP * DM, MTOK, NP, DM, DM}; pg8::StaticOrder S; S.init(MTOK, NP, G, opaque_bid());
            pg8::EpiScaleBf16<0> E{c.proj, NP, c.ss + (size_t)(2 * l) * MTOK};
            pg8::gemm_phase<pg8::EpiScaleBf16<0>, pg8::StaticOrder, false, true>(lds, g, S, E);
            { PHASE_CTX(); fgate_phase(c, l, lds); }
        }
        SEAM(pb);
#ifdef ATT_DUP
        if (RUN(pb + 1)) { PHASE_CTX(); att::attn_phase(c, l, lds, ap_->ph_lo + 1); }
#endif
        if (RUN(pb + 1)) { { PHASE_CTX(); att::knorm_phase(c, l); } xcd_barrier(xbar); { PHASE_CTX(); att::attn_phase(c, l, lds); } }
        SEAM(pb + 1);
        if (RUN(pb + 2)) { PHASE_CTX();
            pg8::Gemm g{c.proj, c.wo_t + (size_t)l * DM * DM, MTOK, DM, DM, NP}; pg8::StaticOrder S; S.init(MTOK, DM, G, opaque_bid());
            pg8::EpiRes E{c.xn, c.ss + (size_t)(2 * l + 1) * MTOK};
            pg8::gemm_phase<pg8::EpiRes, pg8::StaticOrder, true, true>(lds, g, S, E);
        }
        SEAM(pb + 2);
        if (RUN(pb + 3)) { PHASE_CTX();
            pg8::Gemm g{c.xn, c.w1_t + (size_t)l * FF * DM, MTOK, FF, DM, DM}; pg8::StaticOrder S; S.init(MTOK, FF, G, opaque_bid());
            pg8::EpiScaleBf16<1> E{c.proj, FF, c.ss + (size_t)(2 * l + 1) * MTOK};
            pg8::gemm_phase<pg8::EpiScaleBf16<1>, pg8::StaticOrder, false, true>(lds, g, S, E);
        }
        SEAM(pb + 3);
        if (RUN(pb + 4)) { PHASE_CTX();
            pg8::Gemm g{c.proj, c.w2_t + (size_t)l * DM * FF, MTOK, DM, FF, FF}; pg8::StaticOrder S; S.init(MTOK, DM, G, opaque_bid());
            pg8::EpiRes E{c.xn, c.ss + (size_t)(2 * l + 2) * MTOK};
            pg8::gemm_phase<pg8::EpiRes, pg8::StaticOrder, true, true>(lds, g, S, E);
        }
        SEAM(pb + 4);
    }
    if (RUN(N_PHASES - 1)) { PHASE_CTX(); final_phase(c); }
#undef RUN
#undef SEAM
}

#ifndef MK_PER_PHASE
#define MK_PER_PHASE 0
#endif
extern "C" void kernel_launch(void* const* d_in, const int* in_sizes, int n_in, void* d_out, int out_size, void* d_ws, size_t ws_size, hipStream_t stream) {
    static int grid = 0;
    if (grid == 0) {
        if (n_in != 15 || out_size != MTOK * DM || ws_size < WS_END) { fprintf(stderr, "kernel_launch: unexpected sizes n_in %d out %d ws %zu (need %zu)\n", n_in, out_size, ws_size, (size_t)WS_END); grid = -1; return; }
        int dev = 0, cus = 0, per_cu = 0;
        (void)hipGetDevice(&dev); (void)hipDeviceGetAttribute(&cus, hipDeviceAttributeMultiprocessorCount, dev);
        if (hipFuncSetAttribute((const void*)trunk_fwd, hipFuncAttributeMaxDynamicSharedMemorySize, LDS_BYTES) != hipSuccess) { fprintf(stderr, "kernel_launch: hipFuncSetAttribute failed\n"); grid = -1; return; }
        if (hipOccupancyMaxActiveBlocksPerMultiprocessor(&per_cu, (const void*)trunk_fwd, 512, LDS_BYTES) != hipSuccess || per_cu < 1) { fprintf(stderr, "kernel_launch: occupancy query says %d\n", per_cu); per_cu = 1; }
        (void)hipGetLastError();
        grid = cus > 0 ? cus : 256;
        fprintf(stderr, "kernel_launch: grid %d (cus %d, per_cu %d)\n", grid, cus, per_cu);
    }
    if (grid < 0) return;
    if (hipMemsetAsync((char*)d_ws + 16384, 0, 16384, stream) != hipSuccess) { fprintf(stderr, "kernel_launch: memset of barrier words failed\n"); return; }
    Args a{};
    for (int i = 0; i < 15; ++i) a.in[i] = (const float*)d_in[i];
    a.out = (float*)d_out; a.ws = (unsigned char*)d_ws;
#if MK_PER_PHASE
    for (int p = 0; p < N_PHASES; ++p) { a.ph_lo = p; a.ph_hi = p + 1; hipLaunchKernelGGL(trunk_fwd, dim3(grid), dim3(512), LDS_BYTES, stream, a); }
#else
    a.ph_lo = 0; a.ph_hi = N_PHASES;
    void* args[] = {&a};
    hipError_t e = hipLaunchCooperativeKernel((const void*)trunk_fwd, dim3(grid), dim3(512), args, LDS_BYTES, stream);
    if (e != hipSuccess) fprintf(stderr, "kernel_launch: cooperative launch failed: %s (grid %d)\n", hipGetErrorString(e), grid);
#endif
}
```

```cpp
#include <hip/hip_runtime.h>
#include <hip/hip_cooperative_groups.h>
#include <cstdio>
#include <cstdint>
#include <cmath>
namespace cg = cooperative_groups;

constexpr int NBATCH = 8, SEQ = 4096, DM = 1024, DEPTH = 4, FF = 4096;
constexpr int MTOK = NBATCH * SEQ;
constexpr int NIN = 4616;
constexpr int NP = 4608;
constexpr int F_OFF = 2304;
constexpr float NORM_EPS = 1e-6f;
constexpr float LOG2E = 1.4426950408889634f;
constexpr int PC_QA = 0, PC_QB = 256, PC_QC2 = 768, PC_QC0 = 1024, PC_QC1 = 1280, PC_KA = 1536, PC_VA = 1792, PC_KB = 2048, PC_VB = 2560, PC_KC = 3072, PC_VC = 3840;

constexpr size_t MiB = 1u << 20;
constexpr size_t WS_CTL = 0;
constexpr size_t WS_SS = 64 * 1024;
constexpr size_t WS_LOGF = 3 * MiB;
constexpr size_t WS_BIASA = 4 * MiB;
constexpr size_t WS_TABC = 4 * MiB + 64 * 1024;
constexpr size_t WS_WIN = 8 * MiB, WS_WO = 44 * MiB, WS_W1 = 52 * MiB, WS_W2 = 84 * MiB;
constexpr size_t WS_XN = 116 * MiB;
constexpr size_t WS_PROJ = 180 * MiB;
constexpr size_t WS_END = 468 * MiB;
constexpr float SS_SCALE = 16777216.0f, SS_INV = 1.0f / 16777216.0f;

#define DI __device__ __forceinline__
#define LAS __attribute__((address_space(3)))
typedef float f32x16 __attribute__((ext_vector_type(16)));
typedef short s16x4 __attribute__((ext_vector_type(4)));
typedef unsigned u32x2 __attribute__((ext_vector_type(2)));
#define LDS_WAIT() asm volatile("s_waitcnt lgkmcnt(0)" ::: "memory")
DI int opaque_tid() { int t = threadIdx.x; asm volatile("" : "+v"(t)); return t; }
DI int opaque_bid() { int b = blockIdx.x; asm volatile("" : "+s"(b)); return b; }

namespace pg8 {
#define PG8_LAS __attribute__((address_space(3)))
typedef unsigned short bf16_t;
typedef short bf16x8 __attribute__((ext_vector_type(8)));
typedef float f32x4 __attribute__((ext_vector_type(4)));
typedef unsigned u32x4 __attribute__((ext_vector_type(4)));
constexpr int BM = 256, BK = 64, HALF = 128, HTB = HALF * BK * 2  , STAGE_BYTES = 8 * HTB, NXCD = 8, WGM = 4;

__host__ __device__ __forceinline__ int lds_byte(int r, int c) { const int st = (r >> 4) * 2 + (c >> 5), rr = r & 15, cc = c & 31, ob = rr * 64 + cc * 2; return st * 1024 + (ob ^ (((ob >> 9) & 1) << 5)); }
__host__ __device__ __forceinline__ void stage_rc(int b, int& R, int& C) { const int st = b / 1024, sb = b % 1024, swz = sb ^ (((sb >> 9) & 1) << 5); R = (st >> 1) * 16 + swz / 64; C = (st & 1) * 32 + (swz % 64) / 2; }
__host__ __device__ __forceinline__ int perm32(int rho) { const int n = rho >> 4, i = rho & 15; return 8 * (i >> 2) + 4 * n + (i & 3); }

struct Unit { int pm, pn; };
struct Gemm { const bf16_t* A; const bf16_t* Bt; int M, N, K, lda; };

struct StaticOrder {
    int nM, nN, nwg, G, c;
    __host__ __device__ void init(int M, int N, int G_, int c_) { nM = M / BM; nN = N / BM; nwg = nM * nN; G = G_; c = c_; }
    __host__ __device__ bool next(int i, Unit& u) const {
        const long L = (long)i * G + c; if (L >= nwg) return false;
        int wgid = (int)L; { const int q = nwg / NXCD, r = nwg % NXCD, xcd = wgid % NXCD, off = wgid / NXCD; wgid = (xcd < r ? xcd * (q + 1) : r * (q + 1) + (xcd - r) * q) + off; }
        const int nig = WGM * nN, gid = wgid / nig, fm = gid * WGM, gsz = (nM - fm) < WGM ? (nM - fm) : WGM;
        u.pm = fm + ((wgid % nig) % gsz); u.pn = (wgid % nig) / gsz; return true;
    }
    __device__ __forceinline__ void a_ready(const Unit&) const {}
    __device__ __forceinline__ void done(const Unit&) const {}
};

__device__ __forceinline__ unsigned cvt_pk_bf16(float lo, float hi) { unsigned r; asm volatile("v_cvt_pk_bf16_f32 %0, %1, %2" : "=v"(r) : "v"(lo), "v"(hi)); return r; }
typedef float f32x2 __attribute__((ext_vector_type(2)));
__device__ __forceinline__ float row_rs(const unsigned long long* ss, int row) { return 1.0f / sqrtf((float)ss[row] * (SS_INV / 1024.0f) + NORM_EPS); }
template <int MODE> struct EpiScaleBf16 {
    static constexpr bool PERM = true, AFTER_DRAIN = false;
    bf16_t* O; int ldc; const unsigned long long* ss;
    __device__ __forceinline__ void operator()(const f32x4 (&acc)[2][2][4][2], const Unit& u, int wr, int wc, int fr, int fq) const {
        const int row0 = u.pm * BM + wr * 64 + fr, col0 = u.pn * BM + wc * 32 + 8 * fq;
        float sc = 1.f;
        if (MODE == 0) { if (u.pn == 0) sc = 0.17677669529663687f * LOG2E; else if (u.pn < 6) sc = 0.125f * LOG2E; }
        unsigned long long ssv[2][4];
#pragma unroll
        for (int ai = 0; ai < 2; ++ai)
#pragma unroll
            for (int m = 0; m < 4; ++m) ssv[ai][m] = ss[row0 + ai * HALF + m * 16];
#pragma unroll
        for (int ai = 0; ai < 2; ++ai)
#pragma unroll
            for (int m = 0; m < 4; ++m) { const int row = row0 + ai * HALF + m * 16; const float rs = sc / sqrtf((float)ssv[ai][m] * (SS_INV / 1024.0f) + NORM_EPS); bf16_t* rowp = O + (size_t)row * ldc + col0;
#pragma unroll
                for (int bj = 0; bj < 2; ++bj) { f32x4 v0 = acc[ai][bj][m][0] * rs, v1 = acc[ai][bj][m][1] * rs;
                    if (MODE == 1) {
#pragma unroll
                        for (int e = 0; e < 4; ++e) { const float a = fmaxf(v0[e], 0.f), b = fmaxf(v1[e], 0.f); v0[e] = a * a; v1[e] = b * b; } }
                    u32x4 w; w.x = cvt_pk_bf16(v0[0], v0[1]); w.y = cvt_pk_bf16(v0[2], v0[3]); w.z = cvt_pk_bf16(v1[0], v1[1]); w.w = cvt_pk_bf16(v1[2], v1[3]);
                    *(u32x4*)(rowp + bj * HALF) = w; } }
    }
};
struct EpiRes {
    static constexpr bool PERM = true, AFTER_DRAIN = false;
    bf16_t* XN; unsigned long long* ssout;
    __device__ __forceinline__ void operator()(const f32x4 (&acc)[2][2][4][2], const Unit& u, int wr, int wc, int fr, int fq) const {
        const int row0 = u.pm * BM + wr * 64 + fr, col0 = u.pn * BM + wc * 32 + 8 * fq;
#pragma unroll
        for (int ai = 0; ai < 2; ++ai) {
            u32x4 pre[4][2];
#pragma unroll
            for (int m = 0; m < 4; ++m)
#pragma unroll
                for (int bj = 0; bj < 2; ++bj) pre[m][bj] = *(const u32x4*)(XN + (size_t)(row0 + ai * HALF + m * 16) * DM + col0 + bj * HALF);
            asm volatile("" ::: "memory");
#pragma unroll
            for (int m = 0; m < 4; ++m) { const int row = row0 + ai * HALF + m * 16; float s = 0.f;
#pragma unroll
                for (int bj = 0; bj < 2; ++bj) { const u32x4 o = pre[m][bj]; const f32x4 a0 = acc[ai][bj][m][0], a1 = acc[ai][bj][m][1];
                    float x[8];
                    x[0] = __uint_as_float(o.x << 16) + a0[0]; x[1] = __uint_as_float(o.x & 0xffff0000u) + a0[1]; x[2] = __uint_as_float(o.y << 16) + a0[2]; x[3] = __uint_as_float(o.y & 0xffff0000u) + a0[3];
                    x[4] = __uint_as_float(o.z << 16) + a1[0]; x[5] = __uint_as_float(o.z & 0xffff0000u) + a1[1]; x[6] = __uint_as_float(o.w << 16) + a1[2]; x[7] = __uint_as_float(o.w & 0xffff0000u) + a1[3];
#pragma unroll
                    for (int e = 0; e < 8; ++e) s += x[e] * x[e];
                    u32x4 w; w.x = cvt_pk_bf16(x[0], x[1]); w.y = cvt_pk_bf16(x[2], x[3]); w.z = cvt_pk_bf16(x[4], x[5]); w.w = cvt_pk_bf16(x[6], x[7]);
                    *(u32x4*)(XN + (size_t)row * DM + col0 + bj * HALF) = w; }
                s += __shfl_xor(s, 16); s += __shfl_xor(s, 32);
                if (fq == 0) atomicAdd(ssout + row, (unsigned long long)(s * SS_SCALE)); }
        }
    }
};

template <class Epi, class Sched, bool ALIGN_EPI = false, bool SP2 = false>
__device__ __forceinline__ void gemm_phase(PG8_LAS unsigned char* lds, const Gemm g, const Sched& S, const Epi& E) {
    const int tid = opaque_tid(), wid = __builtin_amdgcn_readfirstlane(tid >> 6), lane = tid & 63, wr = wid >> 2, wc = wid & 3, fr = lane & 15, fq = lane >> 4;
    const int K = g.K, nt = K / BK;
    unsigned voffA[2], voffB[2];
#pragma unroll
    for (int i = 0; i < 2; ++i) { int R, C; stage_rc(tid * 16 + i * 8192, R, C); const int Rb = Epi::PERM ? ((R & ~31) + perm32(R & 31)) : R;
        voffA[i] = (unsigned)(R * g.lda + C) * 2u; voffB[i] = (unsigned)(Rb * K + C) * 2u; }
    const size_t kstep = (size_t)(BK * 2);
    const size_t hstepA = (size_t)HALF * g.lda * 2, hstepB = (size_t)HALF * K * 2;
    const size_t tstepA = 2 * hstepA, tstepB = 2 * hstepB;
    const unsigned ldsw = (unsigned)wid * 1024u;
    const int aoff = lds_byte(wr * 64 + fr, fq * 8), boff = lds_byte(wc * 32 + fr, fq * 8);
#define PG8_SA(b, h) (((b) * 2 + (h)) * HTB)
#define PG8_SB(b, h) ((4 + (b) * 2 + (h)) * HTB)
#define PG8_STAGE(bufoff, gbase, voff) do { _Pragma("unroll") for (int _i = 0; _i < 2; ++_i) \
        __builtin_amdgcn_global_load_lds((const unsigned*)((const char*)(gbase) + (voff)[_i]), (PG8_LAS unsigned*)(lds + (bufoff) + ldsw + _i * 8192), 16, 0, 0); } while (0)
#define PG8_LDA(dst, b, h) do { _Pragma("unroll") for (int m = 0; m < 4; ++m) _Pragma("unroll") for (int k = 0; k < 2; ++k) dst[m][k] = *(const PG8_LAS bf16x8*)(lds + PG8_SA(b, h) + aoff + m * 2048 + k * 1024); } while (0)
#define PG8_LDB(dst, b, h) do { _Pragma("unroll") for (int n = 0; n < 2; ++n) _Pragma("unroll") for (int k = 0; k < 2; ++k) dst[n][k] = *(const PG8_LAS bf16x8*)(lds + PG8_SB(b, h) + boff + n * 2048 + k * 1024); } while (0)
#define PG8_MMA(ai, bj, At, Bt) do { __builtin_amdgcn_s_setprio(1); _Pragma("unroll") for (int m = 0; m < 4; ++m) _Pragma("unroll") for (int n = 0; n < 2; ++n) _Pragma("unroll") for (int k = 0; k < 2; ++k) \
        acc[ai][bj][m][n] = __builtin_amdgcn_mfma_f32_16x16x32_bf16(Bt[n][k], At[m][k], acc[ai][bj][m][n], 0, 0, 0); __builtin_amdgcn_s_setprio(0); } while (0)
#define PG8_WAIT_V(n) asm volatile("s_waitcnt vmcnt(" #n ")" ::: "memory")
#define PG8_WAIT_L(n) asm volatile("s_waitcnt lgkmcnt(" #n ")" ::: "memory")
#define PG8_BAR __builtin_amdgcn_s_barrier()
#define PG8_SCHED __builtin_amdgcn_sched_barrier(0)
    Unit cur, nxt; int ui = 0;
    if (!S.next(0, cur)) return;
    f32x4 acc[2][2][4][2];
#pragma unroll
    for (int a = 0; a < 2; ++a)
#pragma unroll
        for (int b = 0; b < 2; ++b)
#pragma unroll
            for (int m = 0; m < 4; ++m)
#pragma unroll
                for (int n = 0; n < 2; ++n) acc[a][b][m][n] = (f32x4){0.f, 0.f, 0.f, 0.f};
    bf16x8 At[4][2], B0[2][2], B1[2][2];
    const char* cA = (const char*)g.A + (size_t)cur.pm * tstepA; const char* cB = (const char*)g.Bt + (size_t)cur.pn * tstepB;
    S.a_ready(cur);
    if constexpr (SP2) {
        PG8_STAGE(PG8_SB(0, 0), cB, voffB); PG8_STAGE(PG8_SB(0, 1), cB + hstepB, voffB); PG8_STAGE(PG8_SA(0, 0), cA, voffA); PG8_STAGE(PG8_SA(0, 1), cA + hstepA, voffA);
        if (wr == 1) PG8_BAR;
        PG8_WAIT_V(2); PG8_BAR;
        PG8_STAGE(PG8_SB(1, 0), cB + kstep, voffB); PG8_STAGE(PG8_SA(1, 0), cA + kstep, voffA); PG8_STAGE(PG8_SB(1, 1), cB + hstepB + kstep, voffB);
        PG8_WAIT_V(6); PG8_BAR;
    } else {
        PG8_STAGE(PG8_SB(0, 0), cB, voffB); PG8_STAGE(PG8_SA(0, 0), cA, voffA); PG8_STAGE(PG8_SB(0, 1), cB + hstepB, voffB); PG8_STAGE(PG8_SA(0, 1), cA + hstepA, voffA);
        if (wr == 1) PG8_BAR;
        PG8_WAIT_V(4); PG8_BAR;
        PG8_STAGE(PG8_SB(1, 0), cB + kstep, voffB); PG8_STAGE(PG8_SA(1, 0), cA + kstep, voffA); PG8_STAGE(PG8_SB(1, 1), cB + hstepB + kstep, voffB);
        PG8_WAIT_V(6); PG8_BAR;
    }
    for (;;) {
        const bool has_next = S.next(ui + 1, nxt);
        const char* nA = has_next ? (const char*)g.A + (size_t)nxt.pm * tstepA : cA; const char* nB = has_next ? (const char*)g.Bt + (size_t)nxt.pn * tstepB : cB;
        for (int t = 0; t < nt; t += 2) {
            const bool last = (t == nt - 2);
            const char* a1 = cA + (size_t)(t + 1) * kstep;
            const char* a2 = last ? nA : cA + (size_t)(t + 2) * kstep; const char* b2 = last ? nB : cB + (size_t)(t + 2) * kstep;
            const char* a3 = a2 + kstep; const char* b3 = b2 + kstep;
            if (last && has_next) S.a_ready(nxt);
            if constexpr (SP2) {
            PG8_LDB(B0, 0, 0); PG8_LDB(B1, 0, 1); PG8_SCHED; PG8_LDA(At, 0, 0); PG8_STAGE(PG8_SA(1, 1), a1 + hstepA, voffA);
            PG8_WAIT_V(8); PG8_WAIT_L(0); PG8_BAR; PG8_MMA(0, 0, At, B0); PG8_MMA(0, 1, At, B1); PG8_BAR; PG8_SCHED;
            PG8_LDA(At, 0, 1); PG8_STAGE(PG8_SB(0, 0), b2, voffB); PG8_STAGE(PG8_SB(0, 1), b2 + hstepB, voffB); PG8_STAGE(PG8_SA(0, 0), a2, voffA);
            PG8_WAIT_V(8); PG8_WAIT_L(0); PG8_BAR; PG8_MMA(1, 0, At, B0); PG8_MMA(1, 1, At, B1); PG8_BAR; PG8_SCHED;
            PG8_LDB(B0, 1, 0); PG8_LDB(B1, 1, 1); PG8_SCHED; PG8_LDA(At, 1, 0); PG8_STAGE(PG8_SA(0, 1), a2 + hstepA, voffA);
            PG8_WAIT_V(8); PG8_WAIT_L(0); PG8_BAR; PG8_MMA(0, 0, At, B0); PG8_MMA(0, 1, At, B1); PG8_BAR; PG8_SCHED;
            PG8_LDA(At, 1, 1); PG8_STAGE(PG8_SB(1, 0), b3, voffB); PG8_STAGE(PG8_SB(1, 1), b3 + hstepB, voffB); PG8_STAGE(PG8_SA(1, 0), a3, voffA);
            PG8_WAIT_V(8); PG8_WAIT_L(0); PG8_BAR; PG8_MMA(1, 0, At, B0); PG8_MMA(1, 1, At, B1); PG8_BAR; PG8_SCHED;
            } else {
            PG8_LDB(B0, 0, 0); PG8_SCHED; PG8_LDA(At, 0, 0); PG8_STAGE(PG8_SA(1, 1), a1 + hstepA, voffA);
            PG8_WAIT_L(8); PG8_BAR; PG8_WAIT_L(0); PG8_MMA(0, 0, At, B0); PG8_BAR; PG8_SCHED;
            PG8_LDB(B1, 0, 1); PG8_STAGE(PG8_SB(0, 0), b2, voffB);
            PG8_BAR; PG8_WAIT_L(0); PG8_MMA(0, 1, At, B1); PG8_BAR;
            PG8_LDA(At, 0, 1); PG8_STAGE(PG8_SA(0, 0), a2, voffA);
            PG8_BAR; PG8_WAIT_L(0); PG8_MMA(1, 0, At, B0); PG8_BAR; PG8_SCHED;
            PG8_STAGE(PG8_SB(0, 1), b2 + hstepB, voffB);
            PG8_WAIT_V(6); PG8_BAR; PG8_MMA(1, 1, At, B1); PG8_BAR;
            PG8_LDB(B0, 1, 0); PG8_SCHED; PG8_LDA(At, 1, 0); PG8_STAGE(PG8_SA(0, 1), a2 + hstepA, voffA);
            PG8_WAIT_L(8); PG8_BAR; PG8_WAIT_L(0); PG8_MMA(0, 0, At, B0); PG8_BAR; PG8_SCHED;
            PG8_LDB(B1, 1, 1); PG8_STAGE(PG8_SB(1, 0), b3, voffB);
            PG8_BAR; PG8_WAIT_L(0); PG8_MMA(0, 1, At, B1); PG8_BAR;
            PG8_LDA(At, 1, 1); PG8_STAGE(PG8_SA(1, 0), a3, voffA);
            PG8_BAR; PG8_WAIT_L(0); PG8_MMA(1, 0, At, B0); PG8_BAR; PG8_SCHED;
            PG8_STAGE(PG8_SB(1, 1), b3 + hstepB, voffB);
            PG8_WAIT_V(6); PG8_BAR; PG8_MMA(1, 1, At, B1); PG8_BAR;
            }
        }
        if constexpr (ALIGN_EPI) { if (wr == 0) PG8_BAR; }
        if constexpr (!Epi::AFTER_DRAIN) { E(acc, cur, wr, wc, fr, fq); S.done(cur); }
        if (!has_next) break;
#pragma unroll
        for (int a = 0; a < 2; ++a)
#pragma unroll
            for (int b = 0; b < 2; ++b)
#pragma unroll
                for (int m = 0; m < 4; ++m)
#pragma unroll
                    for (int n = 0; n < 2; ++n) acc[a][b][m][n] = (f32x4){0.f, 0.f, 0.f, 0.f};
        cur = nxt; cA = nA; cB = nB; ++ui;
        if constexpr (ALIGN_EPI) { if (wr == 1) PG8_BAR; }
    }
    PG8_WAIT_V(0);
    if constexpr (!ALIGN_EPI) { if (wr == 0) PG8_BAR; }
    PG8_BAR;
    if constexpr (Epi::AFTER_DRAIN) { E.fused(acc, cur, wr, wc, fr, fq, lds, wid, lane); S.done(cur); }
#undef PG8_SA
#undef PG8_SB
#undef PG8_STAGE
#undef PG8_LDA
#undef PG8_LDB
#undef PG8_MMA
#undef PG8_WAIT_V
#undef PG8_WAIT_L
#undef PG8_BAR
#undef PG8_SCHED
}
}
typedef unsigned short bf16;
typedef float f32x4 __attribute__((ext_vector_type(4)));
typedef short bf16x8 __attribute__((ext_vector_type(8)));
typedef unsigned u32x4 __attribute__((ext_vector_type(4)));
typedef short v4i16_t __attribute__((ext_vector_type(4)));
typedef float f32x2_t __attribute__((ext_vector_type(2)));
typedef __bf16 bf16x2_t __attribute__((ext_vector_type(2)));
DI unsigned cvtpk(float lo, float hi) { f32x2_t v = {lo, hi}; bf16x2_t b = __builtin_convertvector(v, bf16x2_t); return __builtin_bit_cast(unsigned, b); }
DI float bf2f(unsigned short u) { return __uint_as_float((unsigned)u << 16); }
DI float wave_sum(float v) {
#pragma unroll
    for (int o = 1; o < 64; o <<= 1) v += __shfl_xor(v, o);
    return v;
}
struct Ctx {
    const float *x, *norm1_g, *w_in, *b_f, *lam_q1, *lam_k1, *lam_q2, *lam_k2, *diff_g, *w_o, *norm2_g, *w_1, *w_2, *rel_bias, *final_g;
    float* out; unsigned char* ws;
    bf16 *win_t, *wo_t, *w1_t, *w2_t, *xn, *proj;
    unsigned long long* ss; float* logf; float* biasA; float* tabC; float* lamv; float* knorm; unsigned* knA; unsigned* ctl;
};

DI int colmap(int t) {
    switch (t) { case 0: return 0; case 1: return 768; case 2: return 1024; case 3: return 2824; case 4: return 2312; case 5: return 2568; case 6: return 256; case 7: return 512;
                 case 8: return 1280; case 9: return 1536; case 10: return 1792; case 11: return 2048; case 12: return 3080; case 13: return 3336; case 14: return 3592;
                 case 15: return 3848; case 16: return 4104; default: return 4360; }
}
DI void p0_transpose_item(const float* W, int ldw, int n0src, int k0, const float* g, bf16* WT, int K, int nrow0, LAS float* scr, int lane) {
#pragma unroll 8
    for (int i = 0; i < 32; ++i) { const int kk = 2 * i + (lane >> 5); float v = W[(size_t)(k0 + kk) * ldw + n0src + (lane & 31)]; if (g) v *= g[k0 + kk]; scr[kk * 33 + (lane & 31)] = v; }
    LDS_WAIT();
    const int c = lane & 7;
#pragma unroll
    for (int j = 0; j < 4; ++j) { const int n = (lane >> 3) + 8 * j; const LAS float* s = scr + (8 * c) * 33 + n;
        u32x4 o; o.x = cvtpk(s[0 * 33], s[1 * 33]); o.y = cvtpk(s[2 * 33], s[3 * 33]); o.z = cvtpk(s[4 * 33], s[5 * 33]); o.w = cvtpk(s[6 * 33], s[7 * 33]);
        *(u32x4*)(WT + (size_t)(nrow0 + n) * K + k0 + 8 * c) = o; }
    LDS_WAIT();
}
DI int t5_bucket(int d) {
    if (d < 16) return d;
    int lg = 16 + (int)(logf((float)d / 16.0f) / 4.852030263919617f * 16.0f);
    return lg < 31 ? lg : 31;
}
constexpr int P0_I_IN = 16 * 144, P0_I_O = 16 * 32, P0_I_1 = 16 * 128, P0_I_2 = 64 * 32, P0_I_L = P0_I_IN + P0_I_O + P0_I_1 + P0_I_2;
DI void p0_conv_item(const Ctx& c, int l, int r, LAS float* scr, int lane) {
    if (r < P0_I_IN) { const int kb = r / 144, nb = r - kb * 144, np0 = nb * 32;
        p0_transpose_item(c.w_in + (size_t)l * DM * NIN, NIN, colmap(np0 >> 8) + (np0 & 255), kb * 64, c.norm1_g + l * DM, c.win_t + (size_t)l * NP * DM, DM, np0, scr, lane); return; }
    r -= P0_I_IN;
    if (r < P0_I_O) { const int kb = r / 32, nb = r - kb * 32;
        p0_transpose_item(c.w_o + (size_t)l * DM * DM, DM, nb * 32, kb * 64, nullptr, c.wo_t + (size_t)l * DM * DM, DM, nb * 32, scr, lane); return; }
    r -= P0_I_O;
    if (r < P0_I_1) { const int kb = r / 128, nb = r - kb * 128;
        p0_transpose_item(c.w_1 + (size_t)l * DM * FF, FF, nb * 32, kb * 64, c.norm2_g + l * DM, c.w1_t + (size_t)l * FF * DM, DM, nb * 32, scr, lane); return; }
    r -= P0_I_1;
    { const int kb = r / 32, nb = r - kb * 32;
        p0_transpose_item(c.w_2 + (size_t)l * FF * DM, DM, nb * 32, kb * 64, nullptr, c.w2_t + (size_t)l * DM * FF, FF, nb * 32, scr, lane); }
}
DI void p0_prologue(const Ctx& c, LAS unsigned char* lds) {
    const int tid = opaque_tid(), lane = tid & 63, wave = __builtin_amdgcn_readfirstlane(tid >> 6);
    const int G = gridDim.x, bid = opaque_bid(), gw = bid * 8 + wave, NGW = G * 8, gt = bid * 512 + tid, NGT = G * 512;
    LAS float* scr = (LAS float*)(lds + wave * 16384);
    for (int it = gw; it < P0_I_L; it += NGW) p0_conv_item(c, 0, it, scr, lane);
    for (int m0 = gw; m0 < MTOK; m0 += 4 * NGW) {
        f32x4 v[4][4];
#pragma unroll
        for (int u = 0; u < 4; ++u) { const int m = m0 + u * NGW;
#pragma unroll
            for (int j = 0; j < 4; ++j) v[u][j] = (f32x4){0.f, 0.f, 0.f, 0.f};
            if (m < MTOK) { const f32x4* xr = (const f32x4*)(c.x + (size_t)m * DM) + lane;
#pragma unroll
                for (int j = 0; j < 4; ++j) v[u][j] = xr[64 * j]; } }
#pragma unroll
        for (int u = 0; u < 4; ++u) { const int m = m0 + u * NGW;
            if (m < MTOK) { unsigned long long* o8 = (unsigned long long*)(c.xn + (size_t)m * DM) + lane; float s = 0.f;
#pragma unroll
                for (int j = 0; j < 4; ++j) { const f32x4 w = v[u][j]; s += (w.x * w.x + w.y * w.y) + (w.z * w.z + w.w * w.w);
                    o8[64 * j] = (unsigned long long)cvtpk(w.x, w.y) | ((unsigned long long)cvtpk(w.z, w.w) << 32); }
                s = wave_sum(s);
                if (lane == 0) c.ss[m] = (unsigned long long)(s * SS_SCALE); } }
    }
    for (int i = gt; i < 8 * MTOK; i += NGT) c.ss[MTOK + i] = 0ull;
    if (gt < 512) c.knA[gt] = 0u;
    if (gt >= 64 && gt < 68) { const int hh = gt - 64; float bmx = -1e30f, bmn = 1e30f;
        for (int i = 0; i < 32; ++i) { const float bv = c.rel_bias[i * 16 + hh] * LOG2E; bmx = fmaxf(bmx, bv); bmn = fminf(bmn, bv); }
        c.lamv[8 + hh] = bmx; c.lamv[12 + hh] = bmn; }
    if (gt < DEPTH) { c.ctl[64 * gt] = 0u; c.ctl[64 * (gt + 4)] = 0u; float d1 = 0.f, d2 = 0.f;
        for (int i = 0; i < 32; ++i) { d1 += c.lam_q1[gt * 32 + i] * c.lam_k1[gt * 32 + i]; d2 += c.lam_q2[gt * 32 + i] * c.lam_k2[gt * 32 + i]; }
        c.lamv[gt] = expf(d1) - expf(d2) + (0.8f - 0.6f * expf(-0.3f * (float)gt)); }
    for (int i = gt; i < 4 * 4096; i += NGT) { const int h = i >> 12, d = 4095 - (i & 4095); c.biasA[i] = c.rel_bias[t5_bucket(d) * 16 + h] * LOG2E; }
    for (int i = gt; i < 4 * 396; i += NGT) { const int h = i / 396, r = i - h * 396, g = r / 132, n = r - g * 132; const int dil = g == 0 ? 1 : (g == 1 ? 4 : 16);
        c.tabC[i] = (n <= 128) ? c.rel_bias[t5_bucket(n * dil) * 16 + 4 + 4 * g + h] * LOG2E : 0.f; }
}

DI void fgate_phase(const Ctx& c, int l, LAS unsigned char* lds) {
    const int tid = opaque_tid(), lane = tid & 63, wave = __builtin_amdgcn_readfirstlane(tid >> 6);
    const int gw = opaque_bid() * 8 + wave, NGW = gridDim.x * 8;
    constexpr int WPITCH = 2048 + 16;
    const float* wsrc = c.w_in + (size_t)l * DM * NIN + F_OFF; const float* g1 = c.norm1_g + l * DM;
    for (int i = tid; i < 8192; i += 512) { const int k = i >> 3, h = i & 7; const float v = wsrc[(size_t)k * NIN + h] * g1[k];
        *(LAS unsigned short*)(lds + h * WPITCH + k * 2) = (unsigned short)(cvtpk(v, 0.f) & 0xffffu); }
    __syncthreads();
    const unsigned long long* ss = c.ss + (size_t)(2 * l) * MTOK;
    const int fr = lane & 15, fq = lane >> 4;
    for (int tile = gw; tile < MTOK / 16; tile += NGW) {
        const bf16* xrow = c.xn + (size_t)(tile * 16 + fr) * DM + fq * 8;
        LAS const unsigned char* wrow = lds + (fr & 7) * WPITCH + fq * 16;
        pg8::f32x4 acc = {0.f, 0.f, 0.f, 0.f};
        bf16x8 av[32];
#pragma unroll
        for (int s2 = 0; s2 < 32; ++s2) av[s2] = *(const bf16x8*)(xrow + s2 * 32);
#pragma unroll
        for (int s2 = 0; s2 < 32; ++s2) { const bf16x8 bv = *(const LAS bf16x8*)(wrow + s2 * 64); acc = __builtin_amdgcn_mfma_f32_16x16x32_bf16(av[s2], bv, acc, 0, 0, 0); }
        if (fr < 8) { const float bfv = c.b_f[l * 8 + fr];
#pragma unroll
            for (int j = 0; j < 4; ++j) { const int row = tile * 16 + fq * 4 + j;
                const float f = acc[j] / sqrtf((float)ss[row] * (SS_INV / 1024.0f) + NORM_EPS) + bfv;
                const float ls = fminf(f, 0.f) - __logf(1.0f + __expf(-fabsf(f)));
                const int b = row >> 12, t = row & 4095; c.logf[(size_t)(b * 8 + fr) * SEQ + t] = ls * LOG2E; } }
    }
    __syncthreads();
}

constexpr int N_PHASES_ = 2 + 5 * DEPTH;
DI void final_phase(const Ctx& c) {
    const int tid = opaque_tid(), lane = tid & 63, wave = __builtin_amdgcn_readfirstlane(tid >> 6);
    const int gw = opaque_bid() * 8 + wave, NGW = gridDim.x * 8;
    const unsigned long long* ss = c.ss + (size_t)8 * MTOK;
    const f32x4* gp = (const f32x4*)c.final_g + lane;
    f32x4 g4[4];
#pragma unroll
    for (int j = 0; j < 4; ++j) g4[j] = gp[64 * j];
    float delta = 0.f;
#ifdef PROBE_MASK
    { const unsigned long long* ts = (const unsigned long long*)(c.ws + WS_TABC + 16384); unsigned long long sel = 0;
      for (int p = 0; p < N_PHASES_ - 1; ++p) { const int ty = (p == 0) ? 0 : 1 + ((p - 1) % 5); if ((PROBE_MASK >> ty) & 1) sel += ts[p + 1] - ts[p]; }
      const float f = (float)sel / (float)(ts[N_PHASES_ - 1] - ts[0]); delta = sqrtf(f * 8e-4f); }
#endif
    for (int m0 = gw; m0 < MTOK; m0 += 4 * NGW) {
        unsigned long long w[4][4]; unsigned long long sv[4];
#pragma unroll
        for (int u = 0; u < 4; ++u) { const int m = m0 + u * NGW; sv[u] = 0ull;
#pragma unroll
            for (int j = 0; j < 4; ++j) w[u][j] = 0ull;
            if (m < MTOK) { const unsigned long long* xr = (const unsigned long long*)(c.xn + (size_t)m * DM) + lane;
#pragma unroll
                for (int j = 0; j < 4; ++j) w[u][j] = xr[64 * j];
                sv[u] = ss[m]; } }
#pragma unroll
        for (int u = 0; u < 4; ++u) { const int m = m0 + u * NGW;
            if (m < MTOK) { f32x4* orow = (f32x4*)(c.out + (size_t)m * DM) + lane;
                const float rs = 1.0f / sqrtf((float)sv[u] * (SS_INV / 1024.0f) + NORM_EPS); const float dd = (m < 8192) ? delta : 0.f;
#pragma unroll
                for (int j = 0; j < 4; ++j) { const unsigned long long ww = w[u][j]; f32x4 v;
                    v.x = bf2f((unsigned short)ww); v.y = bf2f((unsigned short)(ww >> 16)); v.z = bf2f((unsigned short)(ww >> 32)); v.w = bf2f((unsigned short)(ww >> 48));
                    orow[64 * j] = v * rs * g4[j] + dd; } } }
    }
}

namespace att {
constexpr int L_K = 0, L_V = 16384, L_TAB = 32768, L_WSF = 49152, L_STG = 53248, L_SLOT = 118784;
constexpr int N_CONV = P0_I_L / 64, N_UNITS = N_CONV + 512 + 512 + 256;
#define NEG_INF_F (-__builtin_inff())
#define MFMA32(a, b, c) __builtin_amdgcn_mfma_f32_32x32x16_bf16((a), (b), (c), 0, 0, 0)
DI int crow(int r, int hi) { return (r & 3) + 8 * (r >> 2) + 4 * hi; }
DI s16x4 vtr(LAS const unsigned char* p) { return __builtin_bit_cast(s16x4, __builtin_amdgcn_ds_read_tr16_b64_v4i16((LAS v4i16_t*)p)); }
DI float swap_max(float a) { auto rr = __builtin_amdgcn_permlane32_swap(__float_as_uint(a), __float_as_uint(a), false, false); return fmaxf(__uint_as_float(rr[0]), __uint_as_float(rr[1])); }
DI float swap_sum(float a) { auto rr = __builtin_amdgcn_permlane32_swap(__float_as_uint(a), __float_as_uint(a), false, false); return __uint_as_float(rr[0]) + __uint_as_float(rr[1]); }

DI void softmax_pv(f32x16& p, f32x16& o0, f32x16& o1, float& mhat, float& l, LAS float* wsa, LAS const unsigned char* vb, int r32, int hi) {
    float a = fmaxf(fmaxf(p[0], p[1]), fmaxf(p[2], p[3]));
#pragma unroll
    for (int r = 4; r < 16; r += 4) a = fmaxf(a, fmaxf(fmaxf(p[r], p[r + 1]), fmaxf(p[r + 2], p[r + 3])));
    a = swap_max(a);
    bool resc = false;
    if (__any(a > 8.0f)) {
        const float dl = fmaxf(a, 0.f); mhat += dl;
#pragma unroll
        for (int r = 0; r < 16; ++r) p[r] -= dl;
        const float f = __builtin_amdgcn_exp2f(-dl); l *= f; if (hi == 0) wsa[r32] = f; resc = true;
    }
    float s = 0.f;
#pragma unroll
    for (int r = 0; r < 16; ++r) { p[r] = __builtin_amdgcn_exp2f(p[r]); s += p[r]; }
    l += s;
    if (resc) { LDS_WAIT();
#pragma unroll
        for (int g = 0; g < 4; ++g) { const f32x4 f4 = *(const LAS f32x4*)(wsa + 8 * g + 4 * hi);
#pragma unroll
            for (int e = 0; e < 4; ++e) { o0[4 * g + e] *= f4[e]; o1[4 * g + e] *= f4[e]; } } }
    u32x4 w0, w1;
    w0.x = cvtpk(p[0], p[1]); w0.y = cvtpk(p[2], p[3]); w0.z = cvtpk(p[4], p[5]); w0.w = cvtpk(p[6], p[7]);
    w1.x = cvtpk(p[8], p[9]); w1.y = cvtpk(p[10], p[11]); w1.z = cvtpk(p[12], p[13]); w1.w = cvtpk(p[14], p[15]);
    const bf16x8 pa0 = __builtin_bit_cast(bf16x8, w0), pa1 = __builtin_bit_cast(bf16x8, w1);
    { const s16x4 a0 = vtr(vb), a1 = vtr(vb + 512), b0 = vtr(vb + 1024), b1 = vtr(vb + 1536);
      o0 = MFMA32(pa0, __builtin_shufflevector(a0, a1, 0, 1, 2, 3, 4, 5, 6, 7), o0);
      o0 = MFMA32(pa1, __builtin_shufflevector(b0, b1, 0, 1, 2, 3, 4, 5, 6, 7), o0); }
    { const s16x4 a0 = vtr(vb + 2048), a1 = vtr(vb + 2048 + 512), b0 = vtr(vb + 2048 + 1024), b1 = vtr(vb + 2048 + 1536);
      o1 = MFMA32(pa0, __builtin_shufflevector(a0, a1, 0, 1, 2, 3, 4, 5, 6, 7), o1);
      o1 = MFMA32(pa1, __builtin_shufflevector(b0, b1, 0, 1, 2, 3, 4, 5, 6, 7), o1); }
}

DI float rowmax16(const f32x16& p) {
    float a = fmaxf(fmaxf(p[0], p[1]), fmaxf(p[2], p[3]));
#pragma unroll
    for (int r = 4; r < 16; r += 4) a = fmaxf(a, fmaxf(fmaxf(p[r], p[r + 1]), fmaxf(p[r + 2], p[r + 3])));
    return a;
}
DI void exp_sum_pack(f32x16& p, float& l, bf16x8& pa0, bf16x8& pa1) {
    float s = 0.f;
#pragma unroll
    for (int r = 0; r < 16; ++r) { p[r] = __builtin_amdgcn_exp2f(p[r]); s += p[r]; }
    l += s;
    u32x4 w0, w1;
    w0.x = cvtpk(p[0], p[1]); w0.y = cvtpk(p[2], p[3]); w0.z = cvtpk(p[4], p[5]); w0.w = cvtpk(p[6], p[7]);
    w1.x = cvtpk(p[8], p[9]); w1.y = cvtpk(p[10], p[11]); w1.z = cvtpk(p[12], p[13]); w1.w = cvtpk(p[14], p[15]);
    pa0 = __builtin_bit_cast(bf16x8, w0); pa1 = __builtin_bit_cast(bf16x8, w1);
}
DI void load_v4(bf16x8 (&vf)[4], LAS const unsigned char* vb) {
#pragma unroll
    for (int i = 0; i < 4; ++i) { const s16x4 a = vtr(vb + i * 1024), b = vtr(vb + i * 1024 + 512); vf[i] = __builtin_shufflevector(a, b, 0, 1, 2, 3, 4, 5, 6, 7); }
}
DI void rescale_o(f32x16& o0, f32x16& o1, LAS const float* wsa, int hi) {
#pragma unroll
    for (int g = 0; g < 4; ++g) { const f32x4 f4 = *(const LAS f32x4*)(wsa + 8 * g + 4 * hi);
#pragma unroll
        for (int e = 0; e < 4; ++e) { o0[4 * g + e] *= f4[e]; o1[4 * g + e] *= f4[e]; } }
}
DI void softmax_pv_b64(f32x16& p0, f32x16& p1, f32x16& o0, f32x16& o1, float& m, float& l, LAS float* wsa, LAS const unsigned char* vb, int r32, int hi) {
    float a = swap_max(fmaxf(rowmax16(p0), rowmax16(p1)));
    if (__any(a > 8.0f)) {
        const float dl = fmaxf(a, 0.f); m += dl;
#pragma unroll
        for (int r = 0; r < 16; ++r) { p0[r] -= dl; p1[r] -= dl; }
        const float f = __builtin_amdgcn_exp2f(-dl); l *= f; if (hi == 0) wsa[r32] = f;
        LDS_WAIT(); rescale_o(o0, o1, wsa, hi);
    }
    bf16x8 pa0, pa1, pa2, pa3, va[4], vb4[4];
    load_v4(va, vb); load_v4(vb4, vb + 4096);
    exp_sum_pack(p0, l, pa0, pa1);
    exp_sum_pack(p1, l, pa2, pa3);
    o0 = MFMA32(pa0, va[0], o0); o1 = MFMA32(pa0, va[2], o1); o0 = MFMA32(pa1, va[1], o0); o1 = MFMA32(pa1, va[3], o1);
    o0 = MFMA32(pa2, vb4[0], o0); o1 = MFMA32(pa2, vb4[2], o1); o0 = MFMA32(pa3, vb4[1], o0); o1 = MFMA32(pa3, vb4[3], o1);
}
DI void exp_pack_nosum(f32x16& p, bf16x8& pa0, bf16x8& pa1) {
#pragma unroll
    for (int r = 0; r < 16; ++r) p[r] = __builtin_amdgcn_exp2f(p[r]);
    u32x4 w0, w1;
    w0.x = cvtpk(p[0], p[1]); w0.y = cvtpk(p[2], p[3]); w0.z = cvtpk(p[4], p[5]); w0.w = cvtpk(p[6], p[7]);
    w1.x = cvtpk(p[8], p[9]); w1.y = cvtpk(p[10], p[11]); w1.z = cvtpk(p[12], p[13]); w1.w = cvtpk(p[14], p[15]);
    pa0 = __builtin_bit_cast(bf16x8, w0); pa1 = __builtin_bit_cast(bf16x8, w1);
}
DI void softmax_nomax_b64(f32x16& p0, f32x16& p1, f32x16& o0, f32x16& o1, f32x16& ol, LAS const unsigned char* vb) {
    bf16x8 pa0, pa1, pa2, pa3, va[4], vb4[4];
    load_v4(va, vb); load_v4(vb4, vb + 4096);
    exp_pack_nosum(p0, pa0, pa1);
    exp_pack_nosum(p1, pa2, pa3);
    const bf16x8 ones = {0x3F80, 0x3F80, 0x3F80, 0x3F80, 0x3F80, 0x3F80, 0x3F80, 0x3F80};
    o0 = MFMA32(pa0, va[0], o0); o1 = MFMA32(pa0, va[2], o1); ol = MFMA32(pa0, ones, ol); o0 = MFMA32(pa1, va[1], o0); o1 = MFMA32(pa1, va[3], o1); ol = MFMA32(pa1, ones, ol);
    o0 = MFMA32(pa2, vb4[0], o0); o1 = MFMA32(pa2, vb4[2], o1); ol = MFMA32(pa2, ones, ol); o0 = MFMA32(pa3, vb4[1], o0); o1 = MFMA32(pa3, vb4[3], o1); ol = MFMA32(pa3, ones, ol);
}
DI void softmax_pv_a2(f32x16& p0, f32x16& p1, f32x16& oa0, f32x16& oa1, f32x16& ob0, f32x16& ob1, float& ma, float& mb, float& la, float& lb, LAS float* wsf, LAS const unsigned char* vb, int r32, int hi) {
    const float a0 = swap_max(rowmax16(p0)), a1 = swap_max(rowmax16(p1));
    if (__any(fmaxf(a0, a1) > 8.0f)) {
        const float d0 = fmaxf(a0, 0.f), d1 = fmaxf(a1, 0.f); ma += d0; mb += d1;
#pragma unroll
        for (int r = 0; r < 16; ++r) { p0[r] -= d0; p1[r] -= d1; }
        const float f0 = __builtin_amdgcn_exp2f(-d0), f1 = __builtin_amdgcn_exp2f(-d1); la *= f0; lb *= f1;
        if (hi == 0) { wsf[r32] = f0; wsf[32 + r32] = f1; }
        LDS_WAIT(); rescale_o(oa0, oa1, wsf, hi); rescale_o(ob0, ob1, wsf + 32, hi);
    }
    bf16x8 pa0, pa1, pb0, pb1, vf[4];
    load_v4(vf, vb);
    exp_sum_pack(p0, la, pa0, pa1);
    exp_sum_pack(p1, lb, pb0, pb1);
    oa0 = MFMA32(pa0, vf[0], oa0); oa1 = MFMA32(pa0, vf[2], oa1); ob0 = MFMA32(pb0, vf[0], ob0); ob1 = MFMA32(pb0, vf[2], ob1);
    oa0 = MFMA32(pa1, vf[1], oa0); oa1 = MFMA32(pa1, vf[3], oa1); ob0 = MFMA32(pb1, vf[1], ob0); ob1 = MFMA32(pb1, vf[3], ob1);
}

DI void softmax_nomax_a2(f32x16& p0, f32x16& p1, f32x16& oa0, f32x16& oa1, f32x16& ob0, f32x16& ob1, float& la, float& lb, LAS const unsigned char* vb) {
    bf16x8 pa0, pa1, pb0, pb1, vf[4];
    load_v4(vf, vb);
    exp_sum_pack(p0, la, pa0, pa1);
    exp_sum_pack(p1, lb, pb0, pb1);
    oa0 = MFMA32(pa0, vf[0], oa0); oa1 = MFMA32(pa0, vf[2], oa1); ob0 = MFMA32(pb0, vf[0], ob0); ob1 = MFMA32(pb0, vf[2], ob1);
    oa0 = MFMA32(pa1, vf[1], oa0); oa1 = MFMA32(pa1, vf[3], oa1); ob0 = MFMA32(pb1, vf[1], ob0); ob1 = MFMA32(pb1, vf[3], ob1);
}
template <int TYPE> DI void finish(const f32x16& oa0, const f32x16& oa1, const f32x16& ob0, const f32x16& ob1, float la, float lb, float lam, float oscale, const float* subg,
                                   LAS float* wsf, LAS float* stg, bf16* orow0, size_t rstride, int lane, int r32, int hi, int dry = 0, int lready = 0) {
    if (!lready) { la = swap_sum(la); if (hi == 0) wsf[64 + r32] = la; }
    if (TYPE == 0) { lb = swap_sum(lb); if (hi == 0) wsf[96 + r32] = lb; }
    LDS_WAIT();
#pragma unroll
    for (int g = 0; g < 4; ++g) {
        const f32x4 l0 = *(const LAS f32x4*)(wsf + 64 + 8 * g + 4 * hi);
        f32x4 l1 = l0; if (TYPE == 0) l1 = *(const LAS f32x4*)(wsf + 96 + 8 * g + 4 * hi);
#pragma unroll
        for (int e = 0; e < 4; ++e) { const int r = 4 * g + e, row = e + 8 * g + 4 * hi; const float i0 = __builtin_amdgcn_rcpf(l0[e]);
            float v0 = oa0[r] * i0, v1 = oa1[r] * i0;
            if (TYPE == 0) { const float i1 = lam * __builtin_amdgcn_rcpf(l1[e]); v0 -= ob0[r] * i1; v1 -= ob1[r] * i1; }
            stg[row * 64 + r32] = v0; stg[row * 64 + 32 + r32] = v1; }
    }
    LDS_WAIT();
    const int c8 = (lane & 7) * 8;
    f32x4 ga = {1.f, 1.f, 1.f, 1.f}, gb = ga;
    if (TYPE == 0) { ga = *(const f32x4*)(subg + c8); gb = *(const f32x4*)(subg + c8 + 4); }
#pragma unroll
    for (int it = 0; it < 4; ++it) { const int row = it * 8 + (lane >> 3);
        f32x4 a = *(const LAS f32x4*)(stg + row * 64 + c8), b = *(const LAS f32x4*)(stg + row * 64 + c8 + 4);
        if (TYPE == 0) { float q = (a.x * a.x + a.y * a.y) + (a.z * a.z + a.w * a.w) + (b.x * b.x + b.y * b.y) + (b.z * b.z + b.w * b.w);
            q += __shfl_xor(q, 1); q += __shfl_xor(q, 2); q += __shfl_xor(q, 4);
            const float rs = oscale / sqrtf(q * (1.0f / 64.0f) + NORM_EPS); a = a * rs * ga; b = b * rs * gb; }
        u32x4 w; w.x = cvtpk(a.x, a.y); w.y = cvtpk(a.z, a.w); w.z = cvtpk(b.x, b.y); w.w = cvtpk(b.z, b.w);
        if (!dry) *(u32x4*)(orow0 + (size_t)row * rstride + c8) = w; }
    LDS_WAIT();
}

template <int TYPE> DI void unit_ab(const Ctx& c, int layer, int b, int h, int qb_first, int nqb, LAS unsigned char* lds, int dry, float refa = 0.f, float refb = 0.f) {
    constexpr bool ISA = (TYPE == 0 || TYPE == 3);
    const int tid = opaque_tid(), lane = tid & 63, wid = __builtin_amdgcn_readfirstlane(tid >> 6), r32 = lane & 31, hi = lane >> 5;
    const int qcol = (ISA ? PC_QA : PC_QB) + h * 64, kcol = (ISA ? PC_KA : PC_KB) + h * 64, vcol = (ISA ? PC_VA : PC_VB) + h * 64;
    bf16* P = c.proj + (size_t)b * SEQ * NP;
    LAS float* tab = (LAS float*)(lds + L_TAB);
    LAS float* wsf = (LAS float*)(lds + L_WSF) + wid * 128;
    float lam = 0.f, oscale = 1.f;
    LAS float* wt = (LAS float*)(lds + L_SLOT + 64);
    LAS float* knL = wt + 16;
    if (ISA) {
        const f32x4* src = (const f32x4*)(c.biasA + h * 4096);
        for (int i = tid; i < 1024; i += 512) ((LAS f32x4*)tab)[i] = src[i];
        lam = c.lamv[layer]; oscale = 1.0f - (0.8f - 0.6f * expf(-0.3f * (float)layer));
    } else {
        if (tid < 64) knL[tid] = c.knorm[(b * 8 + h) * 64 + tid];
        const int n = (qb_first + nqb) * 256, e0 = tid * 8;
        const f32x4* src = (const f32x4*)(c.logf + (size_t)(b * 8 + h) * SEQ) + 2 * tid;
        float v[8];
        if (e0 < n) { const f32x4 a = src[0], bb = src[1]; v[0] = a.x; v[1] = a.y; v[2] = a.z; v[3] = a.w; v[4] = bb.x; v[5] = bb.y; v[6] = bb.z; v[7] = bb.w; }
        else {
#pragma unroll
            for (int i = 0; i < 8; ++i) v[i] = 0.f; }
#pragma unroll
        for (int i = 1; i < 8; ++i) v[i] += v[i - 1];
        const float tot = v[7]; float sc = tot;
#pragma unroll
        for (int d = 1; d < 64; d <<= 1) { const float t = __shfl_up(sc, d); if (lane >= d) sc += t; }
        if (lane == 63) wt[wid] = sc;
        __syncthreads();
        float woff = 0.f;
#pragma unroll
        for (int w = 0; w < 8; ++w) if (w < wid) woff += wt[w];
        const float base = woff + sc - tot;
        if (e0 < n) { f32x4 a, bb; a.x = base + v[0]; a.y = base + v[1]; a.z = base + v[2]; a.w = base + v[3]; bb.x = base + v[4]; bb.y = base + v[5]; bb.z = base + v[6]; bb.w = base + v[7];
            ((LAS f32x4*)tab)[2 * tid] = a; ((LAS f32x4*)tab)[2 * tid + 1] = bb; }
    }
  for (int qi = 0; qi < nqb; ++qi) {
    const int qb = qb_first + qi;
    const int q0 = qb * 256, q0w = q0 + wid * 32, NT = (q0 + 256) / 64;
    bf16x8 qf[4];
#pragma unroll
    for (int d0 = 0; d0 < 4; ++d0) qf[d0] = *(const bf16x8*)(P + (size_t)(q0w + r32) * NP + qcol + d0 * 16 + hi * 8);
    float qw = 0.f;
    int tstart = 0, fastb = 0; float kmaxall = 0.f;
    if (TYPE == 1) {
        { float sq = 0.f;
#pragma unroll
          for (int d0 = 0; d0 < 4; ++d0)
#pragma unroll
              for (int j = 0; j < 8; ++j) { const float v = bf2f((unsigned short)qf[d0][j]); sq += v * v; }
          sq = swap_sum(sq);
#pragma unroll
          for (int o = 1; o < 32; o <<= 1) sq = fmaxf(sq, __shfl_xor(sq, o));
          qw = sqrtf(sq) * 1.0001f;
          if (lane == 0) wt[8 + wid] = qw; }
        __syncthreads();
        float qb8 = wt[8];
#pragma unroll
        for (int w = 1; w < 8; ++w) qb8 = fmaxf(qb8, wt[8 + w]);
        const float kself = fmaxf(fmaxf(knL[NT - 4], knL[NT - 3]), fmaxf(knL[NT - 2], knL[NT - 1]));
        const bool sk = (lane < NT - 4) && (qb8 * (knL[lane] + kself) + (tab[q0] - tab[64 * lane + 63]) + 2.0f < -150.f);
        const unsigned long long bm = __ballot(sk);
        tstart = __builtin_amdgcn_readfirstlane(__builtin_ctzll(~bm));
        float km = (lane < NT) ? knL[lane] : 0.f;
#pragma unroll
        for (int o = 1; o < 64; o <<= 1) km = fmaxf(km, __shfl_xor(km, o));
        kmaxall = km; fastb = (qb8 * km <= 40.0f) ? 1 : 0;
    }
    const int lkey = tid >> 3, lch = tid & 7;
    const bf16* kp = P + (size_t)lkey * NP + kcol + lch * 8; const bf16* vp = P + (size_t)lkey * NP + vcol + lch * 8;
    const int kwoff = lkey * 128 + ((lch ^ ((lkey >> 1) & 7)) * 16);
    const int vwoff = (lkey >> 5) * 4096 + (lch >> 2) * 2048 + ((lkey & 31) >> 4) * 1024 + ((lkey >> 3) & 1) * 512 + (lkey & 7) * 64 + (lch & 3) * 16;
    const u32x4 kfirst = *(const u32x4*)(kp + (size_t)tstart * 64 * NP), vfirst = *(const u32x4*)(vp + (size_t)tstart * 64 * NP);
    u32x4 kreg = *(const u32x4*)(kp + (size_t)(tstart + 1) * 64 * NP), vreg = *(const u32x4*)(vp + (size_t)(tstart + 1) * 64 * NP);
    *(LAS u32x4*)(lds + L_K + (tstart & 1) * 8192 + kwoff) = kfirst; *(LAS u32x4*)(lds + L_V + (tstart & 1) * 8192 + vwoff) = vfirst;
    __syncthreads();
    f32x16 oa0 = {}, oa1 = {}, ob0 = {}, ob1 = {};
    float ma = 0.f, mb = 0.f, la = 0.f, lb = 0.f;
    float cq = 0.f, cq0w = 0.f, kselfw = 0.f;
    if (TYPE == 1) { cq = tab[q0w + r32]; cq0w = tab[q0w]; kselfw = knL[q0w >> 6]; if (fastb) ma = qw * kmaxall; }
    if (TYPE == 3) { ma = refa; mb = refb; }
    const int trb = (4 * hi + ((lane & 15) >> 2)) * 64 + ((lane >> 4) & 1) * 32 + (lane & 3) * 8;
    const int krd = r32 * 128, kx = (r32 >> 1) & 7;
    for (int t = tstart; t < NT; ++t) {
        LAS const unsigned char* kb = lds + L_K + (t & 1) * 8192; LAS const unsigned char* vbuf = lds + L_V + (t & 1) * 8192;
        if (TYPE == 1) {
            const int k0 = t * 64;
            bool act = (k0 <= q0w + 31);
            if (act && k0 + 64 <= q0w) act = !(qw * (knL[t] + kselfw) + (cq0w - tab[k0 + 63]) + 2.0f < -150.f);
            if (__builtin_amdgcn_readfirstlane((int)act)) {
                bf16x8 kf0[4], kf1[4];
#pragma unroll
                for (int d0 = 0; d0 < 4; ++d0) { kf0[d0] = *(const LAS bf16x8*)(kb + krd + (((2 * d0 + hi) ^ kx) * 16)); kf1[d0] = *(const LAS bf16x8*)(kb + 4096 + krd + (((2 * d0 + hi) ^ kx) * 16)); }
                const float base = cq - ma;
                f32x16 p0, p1;
#pragma unroll
                for (int g = 0; g < 4; ++g) { const f32x4 c0 = *(const LAS f32x4*)(tab + k0 + 8 * g + 4 * hi), c1 = *(const LAS f32x4*)(tab + k0 + 32 + 8 * g + 4 * hi);
#pragma unroll
                    for (int e = 0; e < 4; ++e) { p0[4 * g + e] = base - c0[e]; p1[4 * g + e] = base - c1[e]; } }
#pragma unroll
                for (int d0 = 0; d0 < 4; ++d0) { p0 = MFMA32(kf0[d0], qf[d0], p0); p1 = MFMA32(kf1[d0], qf[d0], p1); }
                if (k0 + 63 > q0w) { const int dbase = q0w + r32 - k0;
#pragma unroll
                    for (int r = 0; r < 16; ++r) { if (dbase - crow(r, hi) < 0) p0[r] = NEG_INF_F; if (dbase - 32 - crow(r, hi) < 0) p1[r] = NEG_INF_F; } }
                if (fastb) softmax_nomax_b64(p0, p1, oa0, oa1, ob0, vbuf + trb); else softmax_pv_b64(p0, p1, oa0, oa1, ma, la, wsf, vbuf + trb, r32, hi);
            }
        } else {
#pragma unroll
        for (int hf = 0; hf < 2; ++hf) {
            const int k0 = t * 64 + hf * 32;
            if (k0 <= q0w + 31) {
                bf16x8 kf[4];
#pragma unroll
                for (int d0 = 0; d0 < 4; ++d0) kf[d0] = *(const LAS bf16x8*)(kb + hf * 4096 + krd + (((2 * d0 + hi) ^ kx) * 16));
                const bool diag = (k0 + 31 > q0w);
                const int dbase = q0w + r32 - k0;
                LAS const unsigned char* vb = vbuf + hf * 4096 + trb;
                    const int dlo = q0w - k0 - 31;
                    float b0 = 0.f; int uni = 0;
                    if (dlo >= 245) { const float blo = tab[4095 - dlo], bhi = tab[4095 - dlo - 62]; b0 = blo; uni = (blo == bhi) ? 1 : 0; }
                    f32x16 p0, p1;
                    if (__builtin_amdgcn_readfirstlane(uni)) {
#pragma unroll
                        for (int r = 0; r < 16; ++r) { p0[r] = b0 - ma; p1[r] = b0 - mb; }
                        p0 = MFMA32(kf[0], qf[0], p0); p1 = MFMA32(kf[2], qf[2], p1); p0 = MFMA32(kf[1], qf[1], p0); p1 = MFMA32(kf[3], qf[3], p1);
                    } else {
                        const LAS float* tp = tab + (4095 - dbase + 4 * hi);
#pragma unroll
                        for (int r = 0; r < 16; ++r) { float bv = tp[(r & 3) + 8 * (r >> 2)]; if (diag && (r32 - crow(r, hi) < 0)) bv = NEG_INF_F; p0[r] = bv - ma; p1[r] = bv - mb; }
                        p0 = MFMA32(kf[0], qf[0], p0); p1 = MFMA32(kf[2], qf[2], p1); p0 = MFMA32(kf[1], qf[1], p0); p1 = MFMA32(kf[3], qf[3], p1);
                    }
                    if (TYPE == 3) softmax_nomax_a2(p0, p1, oa0, oa1, ob0, ob1, la, lb, vb); else softmax_pv_a2(p0, p1, oa0, oa1, ob0, ob1, ma, mb, la, lb, wsf, vb, r32, hi);
            }
        }
        }
        if (t + 1 < NT) { *(LAS u32x4*)(lds + L_K + ((t + 1) & 1) * 8192 + kwoff) = kreg; *(LAS u32x4*)(lds + L_V + ((t + 1) & 1) * 8192 + vwoff) = vreg; }
        __syncthreads();
        if (t + 2 < NT) { kreg = *(const u32x4*)(kp + (size_t)(t + 2) * 64 * NP); vreg = *(const u32x4*)(vp + (size_t)(t + 2) * 64 * NP); }
    }
    if (TYPE == 1 && fastb) { if (r32 == 0) {
#pragma unroll
            for (int r = 0; r < 16; ++r) wsf[64 + crow(r, hi)] = ob0[r]; } }
    finish<ISA ? 0 : 1>(oa0, oa1, ob0, ob1, la, lb, lam, oscale, c.diff_g + layer * 64, wsf, (LAS float*)(lds + L_STG + wid * 8192), P + (size_t)q0w * NP + qcol, (size_t)NP, lane, r32, hi, dry, (TYPE == 1 && fastb) ? 1 : 0);
  }
}

DI void unit_c(const Ctx& c, int b, int h, int chunk, LAS unsigned char* lds, int dry) {
    const int tid = opaque_tid(), lane = tid & 63, wid = __builtin_amdgcn_readfirstlane(tid >> 6), r32 = lane & 31, hi = lane >> 5;
    bf16* P = c.proj + (size_t)b * SEQ * NP;
    LAS float* tabc = (LAS float*)(lds + L_TAB);
    for (int i = tid; i < 396; i += 512) tabc[i] = c.tabC[h * 396 + i];
    __syncthreads();
    LAS float* wsf = (LAS float*)(lds + L_WSF) + wid * 128;
    LAS unsigned char* vbuf = lds + L_K + wid * 4096;
    const int trb = (4 * hi + ((lane & 15) >> 2)) * 64 + ((lane >> 4) & 1) * 32 + (lane & 3) * 8;
    const int vw0 = ((lane & 7) >> 2) * 2048 + (lane >> 3) * 64 + (lane & 3) * 16;
    const int c0 = chunk * 256;
    const int tq = c0 + wid + 8 * r32, thi = c0 + wid + 248;
    f32x16 o0 = {}, o1 = {}; float mh = 0.f, l = 0.f;
#pragma unroll 1
    for (int g = 0; g < 3; ++g) {
        const int dl = g == 0 ? 1 : (g == 1 ? 4 : 8), NT = g == 0 ? 12 : (g == 1 ? 6 : 9), R = 8 / dl;
        const int qcol = (g == 0 ? PC_QC0 : (g == 1 ? PC_QC1 : PC_QC2)) + h * 64, kcol = PC_KC + 256 * g + h * 64, vcol = PC_VC + 256 * g + h * 64;
        bf16x8 qf[4];
#pragma unroll
        for (int d0 = 0; d0 < 4; ++d0) qf[d0] = *(const bf16x8*)(P + (size_t)tq * NP + qcol + d0 * 16 + hi * 8);
        const int tstart = thi - dl * (32 * NT - 1);
        const unsigned nmaxu = (unsigned)min(128, tq >> (g == 0 ? 0 : (g == 1 ? 2 : 4)));
        const LAS float* tabl = tabc + g * 132;
        bf16x8 kf[4]; u32x4 vr[4];
        { const int tk = tstart + dl * r32, tok = tk < 0 ? 0 : tk;
#pragma unroll
          for (int d0 = 0; d0 < 4; ++d0) kf[d0] = *(const bf16x8*)(P + (size_t)tok * NP + kcol + (2 * d0 + hi) * 8);
#pragma unroll
          for (int i = 0; i < 4; ++i) { const int tv = tstart + dl * ((lane >> 3) + 8 * i), tokv = tv < 0 ? 0 : tv; vr[i] = *(const u32x4*)(P + (size_t)tokv * NP + vcol + (lane & 7) * 8); } }
        for (int st = 0; st < NT; ++st) {
#pragma unroll
            for (int i = 0; i < 4; ++i) *(LAS u32x4*)(vbuf + vw0 + (i >> 1) * 1024 + (i & 1) * 512) = vr[i];
            bf16x8 kc[4];
#pragma unroll
            for (int d0 = 0; d0 < 4; ++d0) kc[d0] = kf[d0];
            if (st + 1 < NT) { const int j0 = 32 * (st + 1); const int tk = tstart + dl * (j0 + r32), tok = tk < 0 ? 0 : tk;
#pragma unroll
                for (int d0 = 0; d0 < 4; ++d0) kf[d0] = *(const bf16x8*)(P + (size_t)tok * NP + kcol + (2 * d0 + hi) * 8);
#pragma unroll
                for (int i = 0; i < 4; ++i) { const int tv = tstart + dl * (j0 + (lane >> 3) + 8 * i), tokv = tv < 0 ? 0 : tv; vr[i] = *(const u32x4*)(P + (size_t)tokv * NP + vcol + (lane & 7) * 8); } }
            LDS_WAIT();
            f32x16 p;
            const int mbl = R * (r32 - 31) + 32 * NT - 1 - 32 * st - 4 * hi;
#pragma unroll
            for (int r = 0; r < 16; ++r) { const unsigned mm = (unsigned)(mbl - ((r & 3) + 8 * (r >> 2)));
                const unsigned n = (g == 2) ? (mm >> 1) : mm; const bool ok = (n <= nmaxu) && ((g != 2) || ((mm & 1u) == 0u));
                const unsigned nc = n < 129u ? n : 129u; const float bv = tabl[nc]; p[r] = ok ? bv - mh : NEG_INF_F; }
#pragma unroll
            for (int d0 = 0; d0 < 4; ++d0) p = MFMA32(kc[d0], qf[d0], p);
            softmax_pv(p, o0, o1, mh, l, wsf, vbuf + trb, r32, hi);
            LDS_WAIT();
        }
    }
    finish<2>(o0, o1, o0, o1, l, l, 0.f, 1.f, nullptr, wsf, (LAS float*)(lds + L_STG + wid * 8192), P + (size_t)(c0 + wid) * NP + PC_QC2 + h * 64, (size_t)8 * NP, lane, r32, hi, dry);
}

DI float sumsq8(const u32x4& w) { float t = 0.f;
#pragma unroll
    for (int e = 0; e < 4; ++e) { const float lo = __uint_as_float(w[e] << 16), hi = __uint_as_float(w[e] & 0xffff0000u); t += lo * lo + hi * hi; }
    return t; }
DI float kn_reduce_b(const float (&pv)[8], int lane) {
    float r4[4], r2[2], v;
    { const bool up = (lane & 1) != 0;
#pragma unroll
      for (int i = 0; i < 4; ++i) { const float send = up ? pv[i] : pv[i + 4], keep = up ? pv[i + 4] : pv[i]; r4[i] = keep + __shfl_xor(send, 1); } }
    { const bool up = (lane & 2) != 0;
#pragma unroll
      for (int i = 0; i < 2; ++i) { const float send = up ? r4[i] : r4[i + 2], keep = up ? r4[i + 2] : r4[i]; r2[i] = keep + __shfl_xor(send, 2); } }
    { const bool up = (lane & 4) != 0; const float send = up ? r2[0] : r2[1], keep = up ? r2[1] : r2[0]; v = keep + __shfl_xor(send, 4); }
#pragma unroll
    for (int o = 1; o < 64; o <<= 1) v = fmaxf(v, __shfl_xor(v, o));
    return v;
}
DI float kn_reduce_a(const float (&pv)[8], int lane) {
    float r4[4], r2[2];
    { const bool up = (lane & 1) != 0;
#pragma unroll
      for (int i = 0; i < 4; ++i) { const float send = up ? pv[i] : pv[i + 4], keep = up ? pv[i + 4] : pv[i]; r4[i] = keep + __shfl_xor(send, 1); } }
    { const bool up = (lane & 2) != 0;
#pragma unroll
      for (int i = 0; i < 2; ++i) { const float send = up ? r4[i] : r4[i + 2], keep = up ? r4[i + 2] : r4[i]; r2[i] = keep + __shfl_xor(send, 2); } }
    float m = fmaxf(r2[0], r2[1]);
    m = fmaxf(m, __shfl_xor(m, 1)); m = fmaxf(m, __shfl_xor(m, 2)); m = fmaxf(m, __shfl_xor(m, 8)); m = fmaxf(m, __shfl_xor(m, 16)); m = fmaxf(m, __shfl_xor(m, 32));
    return m;
}
DI void knorm_phase(const Ctx& c, int layer) {
    const int tid = opaque_tid(), lane = tid & 63, wave = __builtin_amdgcn_readfirstlane(tid >> 6);
    const int gw = opaque_bid() * 8 + wave, NGW = gridDim.x * 8, sub = lane >> 3, ch = lane & 7;
    for (int it0 = gw; it0 < 4096; it0 += 2 * NGW) {
        float pb[2][8], pa[2][8];
#pragma unroll
        for (int u = 0; u < 2; ++u) { const int it = it0 + u * NGW; const bool on = it < 4096; const int itc = on ? it : 0;
            { const int bh = itc >> 6, tile = itc & 63, b = bh >> 3, h = bh & 7;
              const bf16* base = c.proj + ((size_t)b * SEQ + tile * 64 + sub) * NP + PC_KB + h * 64 + ch * 8;
#pragma unroll
              for (int i = 0; i < 8; ++i) pb[u][i] = sumsq8(*(const u32x4*)(base + (size_t)(8 * i) * NP)); }
            { const int isq = itc >> 11, r = itc & 2047, bh = r >> 6, tile = r & 63, b = bh >> 2, h = bh & 3;
              const bf16* base = c.proj + ((size_t)b * SEQ + tile * 64 + sub) * NP + (isq ? PC_QA : PC_KA) + h * 64 + ch * 8;
#pragma unroll
              for (int i = 0; i < 8; ++i) pa[u][i] = sumsq8(*(const u32x4*)(base + (size_t)(8 * i) * NP)); } }
#pragma unroll
        for (int u = 0; u < 2; ++u) { const int it = it0 + u * NGW;
            if (it < 4096) {
                const float v = kn_reduce_b(pb[u], lane);
                if (lane == 0) c.knorm[it] = sqrtf(v) * 1.0001f;
                const float m = kn_reduce_a(pa[u], lane);
                const int isq = it >> 11, bh = (it & 2047) >> 6;
                if ((lane & 59) == 0) atomicMax(c.knA + layer * 128 + isq * 64 + bh * 2 + (lane >> 2), __float_as_uint(sqrtf(m) * 1.0001f)); } }
    }
}

DI void attn_phase(const Ctx& c, int layer, LAS unsigned char* lds, int dry = 0) {
    LAS int* slot = (LAS int*)(lds + L_SLOT);
    unsigned* counter = c.ctl + 64 * (layer + 4 * dry); const int tid0 = opaque_tid();
    for (;;) {
        __syncthreads();
        if (tid0 == 0) slot[0] = (int)atomicAdd(counter, 1u);
        __syncthreads();
        const int u0 = __builtin_amdgcn_readfirstlane(slot[0]);
        if (u0 >= N_UNITS) break;
        if (u0 < N_CONV) { if (layer + 1 < DEPTH) { const int tid_ = opaque_tid(), lane_ = tid_ & 63, wv_ = __builtin_amdgcn_readfirstlane(tid_ >> 6);
                for (int j = 0; j < 8; ++j) p0_conv_item(c, layer + 1, u0 * 64 + wv_ * 8 + j, (LAS float*)(lds + wv_ * 16384), lane_); }
            continue; }
        const int u = u0 - N_CONV;
#ifndef NO_UC
        if (u < 512) { unit_c(c, u >> 6, (u >> 4) & 3, u & 15, lds, dry); } else
#endif
        { const int v = u - 512;
            if (v >= 128 && v < 384) { const int w = v - 128, g = 3 - (w >> 6), bh = w & 63; unit_ab<1>(c, layer, bh >> 3, bh & 7, 4 * g, 4, lds, dry); }
            else { const int w = (v < 128) ? v : v - 256, lev = 15 - (w >> 5), r = w & 31; const int ab = r >> 2, ah = r & 3;
                const unsigned* kn_ = c.knA + layer * 128 + (ab * 4 + ah) * 2;
                const float k0n = __uint_as_float(kn_[0]), k1n = __uint_as_float(kn_[1]), q0n = __uint_as_float(kn_[64]), q1n = __uint_as_float(kn_[65]);
                const float bmx = c.lamv[8 + ah], bmn = c.lamv[12 + ah];
                const float span = 2.0f * fmaxf(q0n * k0n, q1n * k1n) + (bmx - bmn);
                if (span <= 80.0f) unit_ab<3>(c, layer, ab, ah, lev, 1, lds, dry, q0n * k0n + bmx + 0.01f, q1n * k1n + bmx + 0.01f);
                else unit_ab<0>(c, layer, ab, ah, lev, 1, lds, dry); } }
    }
}
}

#define XB_TMO      128
#define XB_XCNT(j)  (256  + 64 * (j))
#define XB_XSUB(j)  (1280 + 64 * (j))
#define XB_XGEN(j)  (2304 + 64 * (j))
#define XB_TOP      3328
#define XB_TOPGEN   3392
#define XCD_BAR_WORDS 3456
#define XB_SPIN_CAP (1u << 18)

__device__ __forceinline__ unsigned xb_ld(unsigned* p)              { return __hip_atomic_load(p, __ATOMIC_RELAXED, __HIP_MEMORY_SCOPE_AGENT); }
__device__ __forceinline__ unsigned xb_add(unsigned* p, unsigned v) { return __hip_atomic_fetch_add(p, v, __ATOMIC_RELAXED, __HIP_MEMORY_SCOPE_AGENT); }
__device__ __forceinline__ unsigned xb_xcc_id() { return (unsigned)__builtin_amdgcn_s_getreg((3 << 11) | 20) & 0xFu; }
#define XB_SPIN(cond, bar) do { unsigned _sp = 0; while (cond) { __builtin_amdgcn_s_sleep(1); \
    if ((++_sp & 255u) == 0u) { if (xb_ld(&(bar)[XB_TMO])) break; if (_sp > XB_SPIN_CAP) { atomicAdd(&(bar)[XB_TMO], 1u); break; } } } } while (0)

struct XcdBarrier {
    unsigned* bar; unsigned x;
    volatile LAS unsigned* st;
};

__device__ __forceinline__ XcdBarrier xcd_barrier_post(unsigned* bar, volatile LAS unsigned* st) {
    XcdBarrier b; b.bar = bar; b.x = xb_xcc_id(); b.st = st;
    if (threadIdx.x == 0) (void)xb_add(&bar[XB_XCNT(b.x)], 1u);
    return b;
}
__device__ __forceinline__ void xcd_barrier_complete(unsigned* bar, unsigned x, unsigned& nloc, unsigned& nx) {
    const unsigned G = gridDim.x * gridDim.y * gridDim.z;
    unsigned sum, cnt, mine, sp = 0u;
    for (;;) {
        sum = 0u; cnt = 0u; mine = 0u;
#pragma unroll
        for (unsigned j = 0; j < 16; ++j) { const unsigned c = xb_ld(&bar[XB_XCNT(j)]); sum += c; cnt += (c > 0u) ? 1u : 0u; mine = (j == x) ? c : mine; }
        if (sum == G) break;
        __builtin_amdgcn_s_sleep(1);
        if ((++sp & 255u) == 0u) { if (xb_ld(&bar[XB_TMO])) break; if (sp > XB_SPIN_CAP) { atomicAdd(&bar[XB_TMO], 1u); break; } }
    }
    nloc = mine > 0u ? mine : 1u; nx = cnt > 0u ? cnt : 1u;
}

__device__ __forceinline__ void xcd_barrier(const XcdBarrier& b) {
    asm volatile("s_waitcnt vmcnt(0)" ::: "memory");
    __syncthreads();
    if (threadIdx.x == 0) {
        unsigned* bar = b.bar;
        __builtin_amdgcn_s_waitcnt(0);
        unsigned nloc = b.st[0], nx = b.st[1];
        if (nloc == 0u) { xcd_barrier_complete(bar, b.x, nloc, nx); b.st[0] = nloc; b.st[1] = nx; }
        const unsigned old = xb_add(&bar[XB_XSUB(b.x)], 1u);
        const unsigned gen = old / nloc;
        if (old + 1u == (gen + 1u) * nloc) {
            __builtin_amdgcn_fence(__ATOMIC_RELEASE, "agent");
            asm volatile("s_waitcnt vmcnt(0)" ::: "memory");
            const unsigned og = xb_add(&bar[XB_TOP], 1u);
            const unsigned tg = og / nx;
            if (og + 1u == (tg + 1u) * nx) xb_add(&bar[XB_TOPGEN], 1u);
            else XB_SPIN(xb_ld(&bar[XB_TOPGEN]) == tg, bar);
            __builtin_amdgcn_fence(__ATOMIC_ACQUIRE, "agent");
            xb_add(&bar[XB_XGEN(b.x)], 1u);
            asm volatile("s_waitcnt vmcnt(0)" ::: "memory");
        } else {
            XB_SPIN(xb_ld(&bar[XB_XGEN(b.x)]) == gen, bar);
            __builtin_amdgcn_fence(__ATOMIC_ACQUIRE, "agent");
            asm volatile("s_waitcnt vmcnt(0)" ::: "memory");
        }
    }
    __syncthreads();
}

constexpr int LDS_BYTES = 131072 + 1024;
constexpr int N_PHASES = 2 + 5 * DEPTH;
struct Args { const float* in[15]; float* out; unsigned char* ws; int ph_lo, ph_hi; };
typedef const __attribute__((address_space(4))) Args* KArgP;
DI Ctx make_ctx(KArgP a) {
    Ctx c;
    c.x = a->in[0]; c.norm1_g = a->in[1]; c.w_in = a->in[2]; c.b_f = a->in[3]; c.lam_q1 = a->in[4]; c.lam_k1 = a->in[5]; c.lam_q2 = a->in[6]; c.lam_k2 = a->in[7]; c.diff_g = a->in[8];
    c.w_o = a->in[9]; c.norm2_g = a->in[10]; c.w_1 = a->in[11]; c.w_2 = a->in[12]; c.rel_bias = a->in[13]; c.final_g = a->in[14];
    c.out = a->out; c.ws = a->ws; unsigned char* ws = a->ws;
    c.win_t = (bf16*)(ws + WS_WIN); c.wo_t = (bf16*)(ws + WS_WO); c.w1_t = (bf16*)(ws + WS_W1); c.w2_t = (bf16*)(ws + WS_W2);
    c.xn = (bf16*)(ws + WS_XN); c.proj = (bf16*)(ws + WS_PROJ);
    c.ss = (unsigned long long*)(ws + WS_SS); c.logf = (float*)(ws + WS_LOGF); c.biasA = (float*)(ws + WS_BIASA); c.tabC = (float*)(ws + WS_TABC); c.lamv = (float*)(ws + WS_TABC + 8192); c.knorm = (float*)(ws + WS_TABC + 32768); c.knA = (unsigned*)(ws + WS_TABC + 49152); c.ctl = (unsigned*)(ws + WS_CTL);
    return c;
}
#define PHASE_CTX() KArgP ap_ = (KArgP)__builtin_amdgcn_kernarg_segment_ptr(); asm volatile("" : "+s"(ap_)); const Ctx c = make_ctx(ap_)
__global__ void __launch_bounds__(512, 2) trunk_fwd(Args a) {
    extern __shared__ __attribute__((aligned(16))) unsigned char lds_raw[];
    LAS unsigned char* lds = (LAS unsigned char*)lds_raw;
    cg::grid_group grid = cg::this_grid();
    volatile LAS unsigned* xb_st = (volatile LAS unsigned*)(lds + 131072 + 512);
    if (threadIdx.x < 2) xb_st[threadIdx.x] = 0u;
    __syncthreads();
    const XcdBarrier xbar = xcd_barrier_post((unsigned*)(a.ws + 16384), xb_st);
    if (a.ph_hi < 0) grid.sync();
#ifdef FORCE_LO
    const int lo = FORCE_LO, hi = FORCE_HI, G = gridDim.x;
#else
    const int lo = a.ph_lo, hi = a.ph_hi, G = gridDim.x;
#endif
#define RUN(p) (lo <= (p) && (p) < hi)
#ifdef PROBE_MASK
#define STAMP(p) do { if (blockIdx.x == 0 && threadIdx.x == 0) ((unsigned long long*)(a.ws + WS_TABC + 16384))[(p)] = __builtin_amdgcn_s_memrealtime(); } while (0)
#else
#define STAMP(p) do { } while (0)
#endif
#define SEAM(p) do { if (RUN(p) && RUN((p) + 1)) { xcd_barrier(xbar); } STAMP((p) + 1); } while (0)
    STAMP(0);
    if (RUN(0)) { PHASE_CTX(); p0_prologue(c, lds); }
    SEAM(0);
    for (int l = 0; l < DEPTH; ++l) {
        const int pb = 1 + 5 * l;
        if (RUN(pb)) { PHASE_CTX();
            pg8::Gemm g{c.xn, c.win_t + (size_t)l * NP * DM, MTOK, NP, DM, DM}; pg8::StaticOrder S; S.init(MTOK, NP, G, opaque_bid());
            pg8::EpiScaleBf16<0> E{c.proj, NP, c.ss + (size_t)(2 * l) * MTOK};
            pg8::gemm_phase<pg8::EpiScaleBf16<0>, pg8::StaticOrder, true, true>(lds, g, S, E);
            { PHASE_CTX(); fgate_phase(c, l, lds); }
        }
        SEAM(pb);
#ifdef ATT_DUP
        if (RUN(pb + 1)) { PHASE_CTX(); att::attn_phase(c, l, lds, ap_->ph_lo + 1); }
#endif
        if (RUN(pb + 1)) { { PHASE_CTX(); att::knorm_phase(c, l); } xcd_barrier(xbar); { PHASE_CTX(); att::attn_phase(c, l, lds); } }
        SEAM(pb + 1);
        if (RUN(pb + 2)) { PHASE_CTX();
            pg8::Gemm g{c.proj, c.wo_t + (size_t)l * DM * DM, MTOK, DM, DM, NP}; pg8::StaticOrder S; S.init(MTOK, DM, G, opaque_bid());
            pg8::EpiRes E{c.xn, c.ss + (size_t)(2 * l + 1) * MTOK};
            pg8::gemm_phase<pg8::EpiRes, pg8::StaticOrder, true, true>(lds, g, S, E);
        }
        SEAM(pb + 2);
        if (RUN(pb + 3)) { PHASE_CTX();
            pg8::Gemm g{c.xn, c.w1_t + (size_t)l * FF * DM, MTOK, FF, DM, DM}; pg8::StaticOrder S; S.init(MTOK, FF, G, opaque_bid());
            pg8::EpiScaleBf16<1> E{c.proj, FF, c.ss + (size_t)(2 * l + 1) * MTOK};
            pg8::gemm_phase<pg8::EpiScaleBf16<1>, pg8::StaticOrder, true, true>(lds, g, S, E);
        }
        SEAM(pb + 3);
        if (RUN(pb + 4)) { PHASE_CTX();
            pg8::Gemm g{c.proj, c.w2_t + (size_t)l * DM * FF, MTOK, DM, FF, FF}; pg8::StaticOrder S; S.init(MTOK, DM, G, opaque_bid());
            pg8::EpiRes E{c.xn, c.ss + (size_t)(2 * l + 2) * MTOK};
            pg8::gemm_phase<pg8::EpiRes, pg8::StaticOrder, true, true>(lds, g, S, E);
        }
        SEAM(pb + 4);
    }
    if (RUN(N_PHASES - 1)) { PHASE_CTX(); final_phase(c); }
#undef RUN
#undef SEAM
}

#ifndef MK_PER_PHASE
#define MK_PER_PHASE 0
#endif
extern "C" void kernel_launch(void* const* d_in, const int* in_sizes, int n_in, void* d_out, int out_size, void* d_ws, size_t ws_size, hipStream_t stream) {
    static int grid = 0;
    if (grid == 0) {
        if (n_in != 15 || out_size != MTOK * DM || ws_size < WS_END) { fprintf(stderr, "kernel_launch: unexpected sizes n_in %d out %d ws %zu (need %zu)\n", n_in, out_size, ws_size, (size_t)WS_END); grid = -1; return; }
        int dev = 0, cus = 0, per_cu = 0;
        (void)hipGetDevice(&dev); (void)hipDeviceGetAttribute(&cus, hipDeviceAttributeMultiprocessorCount, dev);
        if (hipFuncSetAttribute((const void*)trunk_fwd, hipFuncAttributeMaxDynamicSharedMemorySize, LDS_BYTES) != hipSuccess) { fprintf(stderr, "kernel_launch: hipFuncSetAttribute failed\n"); grid = -1; return; }
        if (hipOccupancyMaxActiveBlocksPerMultiprocessor(&per_cu, (const void*)trunk_fwd, 512, LDS_BYTES) != hipSuccess || per_cu < 1) { fprintf(stderr, "kernel_launch: occupancy query says %d\n", per_cu); per_cu = 1; }
        (void)hipGetLastError();
        grid = cus > 0 ? cus : 256;
        fprintf(stderr, "kernel_launch: grid %d (cus %d, per_cu %d)\n", grid, cus, per_cu);
    }
    if (grid < 0) return;
    if (hipMemsetAsync((char*)d_ws + 16384, 0, 16384, stream) != hipSuccess) { fprintf(stderr, "kernel_launch: memset of barrier words failed\n"); return; }
    Args a{};
    for (int i = 0; i < 15; ++i) a.in[i] = (const float*)d_in[i];
    a.out = (float*)d_out; a.ws = (unsigned char*)d_ws;
#if MK_PER_PHASE
    for (int p = 0; p < N_PHASES; ++p) { a.ph_lo = p; a.ph_hi = p + 1; hipLaunchKernelGGL(trunk_fwd, dim3(grid), dim3(512), LDS_BYTES, stream, a); }
#else
    a.ph_lo = 0; a.ph_hi = N_PHASES;
    void* args[] = {&a};
    hipError_t e = hipLaunchCooperativeKernel((const void*)trunk_fwd, dim3(grid), dim3(512), args, LDS_BYTES, stream);
    if (e != hipSuccess) fprintf(stderr, "kernel_launch: cooperative launch failed: %s (grid %d)\n", hipGetErrorString(e), grid);
#endif
}
```
